# Optimizing an MI355X kernel written in HIP

```python
import math
import jax, jax.numpy as jnp
from jax import lax
import numpy as np

D_MODEL = 1024
BATCH = 4
SEQ = 8192
DEPTH = 4

GRID_W = 64
FN_GROUPS = 4
FN_GROUP_DIM = 64
FN_WIDTH = FN_GROUPS * FN_GROUP_DIM
NA_HEADS = 8
NA_HEAD_DIM = 64
NA_WIDTH = NA_HEADS * NA_HEAD_DIM
NA_KR_MAX = 8
NA_KC = 16
NA_QC = 16
NA_KCB = 2 * NA_KC
NA_NCB = GRID_W // NA_QC
NEG_INF = -1e30
SSM_GROUPS = 16
SSM_GROUP_DIM = 16
SSM_WIDTH = SSM_GROUPS * SSM_GROUP_DIM
SSM_STATE = 64
DT_MIN = 1e-3
DT_MAX = 1e-1
N_BRANCH = 3
D_FF = 4 * D_MODEL
D_IN = FN_WIDTH + 3 * NA_WIDTH + SSM_WIDTH + N_BRANCH * D_MODEL
RMS_EPS = 1e-6

kernel_name = 'hybrid_fnet_natten_s5_encoder'


def rms_norm(x, g):
    xf = x.astype(jnp.float32)
    y = xf * lax.rsqrt(jnp.mean(xf * xf, axis=-1, keepdims=True) + RMS_EPS)
    return (y * g.astype(jnp.float32)).astype(x.dtype)


def fourier_mix(u):
    b, s, _ = u.shape
    ug = u.astype(jnp.float32).reshape(b, s, FN_GROUPS, FN_GROUP_DIM)
    f = jnp.fft.fftn(ug, axes=(1, 3), norm='ortho')
    return jnp.real(f).reshape(b, s, FN_WIDTH).astype(u.dtype)


def _window_starts(n_pos, n_win):
    pos = np.arange(n_pos)
    return np.clip(pos - n_win // 2, 0, n_pos - n_win)


def neighbourhood_attention(q, k, v, rpb):
    b, s, _ = q.shape
    rows = s // GRID_W
    kr = min(NA_KR_MAX, rows)

    def grid(t):
        return t.reshape(b, rows, GRID_W, NA_HEADS, NA_HEAD_DIM).transpose(0, 3, 1, 2, 4)

    qg, kg, vg = grid(q), grid(k), grid(v)
    key_rows = _window_starts(rows, kr)[:, None] + np.arange(kr)
    qcol = np.arange(GRID_W).reshape(NA_NCB, NA_QC)
    blk_start = np.clip(np.arange(NA_NCB) * NA_QC - NA_KC // 2, 0, GRID_W - NA_KCB)
    key_cols = blk_start[:, None] + np.arange(NA_KCB)
    win_start = _window_starts(GRID_W, NA_KC)[qcol]
    in_win = ((key_cols[:, None, :] >= win_start[:, :, None])
              & (key_cols[:, None, :] < win_start[:, :, None] + NA_KC))

    ri = key_rows[:, None, :, None]
    ci = key_cols[None, :, None, :]
    kb = kg[:, :, ri, ci]
    vb = vg[:, :, ri, ci]
    qb = qg.reshape(b, NA_HEADS, rows, NA_NCB, NA_QC, NA_HEAD_DIM)

    scores = jnp.einsum('bhrjqd,bhrjkcd->bhrjqkc', qb, kb).astype(jnp.float32)
    dr = key_rows - np.arange(rows)[:, None] + NA_KR_MAX - 1
    dc = np.clip(key_cols[:, None, :] - qcol[:, :, None], -(NA_KC - 1), NA_KC - 1) + NA_KC - 1
    bias = rpb[:, dr[:, None, None, :, None], dc[None, :, :, None, :]].astype(jnp.float32)
    scores = jnp.where(in_win[:, :, None, :], scores + bias, NEG_INF)
    p = jax.nn.softmax(scores, axis=(-2, -1)).astype(vb.dtype)
    o = jnp.einsum('bhrjqkc,bhrjkcd->bhrjqd', p, vb)
    o = o.reshape(b, NA_HEADS, rows, GRID_W, NA_HEAD_DIM).transpose(0, 2, 3, 1, 4)
    return o.reshape(b, s, NA_WIDTH)


def _ssm_scan(ug, a_re, a_im, log_dt, b_re, b_im, c_re, c_im, reverse):
    lam = lax.complex(a_re.astype(jnp.float32), a_im.astype(jnp.float32))
    dt = jnp.exp(log_dt.astype(jnp.float32))[:, None]
    lam_bar = jnp.exp(lam * dt)
    b_bar = ((lam_bar - 1.0) / lam)[:, :, None] * lax.complex(
        b_re.astype(jnp.float32), b_im.astype(jnp.float32))
    bu = jnp.einsum('bsgc,gpc->bsgp', ug.astype(jnp.complex64), b_bar)
    a = jnp.broadcast_to(lam_bar, bu.shape)

    def combine(left, right):
        a_l, x_l = left
        a_r, x_r = right
        return a_l * a_r, a_r * x_l + x_r

    _, xs = lax.associative_scan(combine, (a, bu), axis=1, reverse=reverse)
    c = lax.complex(c_re.astype(jnp.float32), c_im.astype(jnp.float32))
    return jnp.real(jnp.einsum('bsgp,gcp->bsgc', xs, c))


def ssm_branch(u, a_re, a_im, log_dt, b_re, b_im, c_re, c_im, d_skip, w_glu):
    b, s, _ = u.shape
    uf = u.astype(jnp.float32)
    ug = uf.reshape(b, s, SSM_GROUPS, SSM_GROUP_DIM)
    y = d_skip.astype(jnp.float32) * uf
    for direction in range(2):
        y = y + _ssm_scan(ug, a_re[direction], a_im[direction], log_dt[direction],
                          b_re[direction], b_im[direction], c_re[direction], c_im[direction],
                          reverse=(direction == 1)).reshape(b, s, SSM_WIDTH)
    y = jax.nn.gelu(y)
    y = y * jax.nn.sigmoid(y @ w_glu.astype(jnp.float32))
    return y.astype(u.dtype)


def setup_inputs(seed: int = 0) -> dict:
    key = jax.random.key(seed)
    ks = jax.random.split(key, 24)
    L = DEPTH

    def nrm(i, shape, scale):
        return scale * jax.random.normal(ks[i], shape, jnp.float32)

    n_idx = jnp.arange(SSM_STATE, dtype=jnp.float32)
    shp_a = (L, 2, SSM_GROUPS, SSM_STATE)
    return {
        'x': nrm(0, (BATCH, SEQ, D_MODEL), 1.0),
        'g_mix': 1.0 + nrm(1, (L, D_MODEL), 0.01),
        'w_in': nrm(2, (L, D_MODEL, D_IN), D_MODEL ** -0.5),
        'na_rpb': nrm(3, (L, NA_HEADS, 2 * NA_KR_MAX - 1, 2 * NA_KC - 1), 0.02),
        'ssm_a_re': -0.5 + nrm(4, shp_a, 0.01),
        'ssm_a_im': math.pi * n_idx + nrm(5, shp_a, 0.01),
        'ssm_log_dt': jax.random.uniform(ks[6], (L, 2, SSM_GROUPS), jnp.float32,
                                         math.log(DT_MIN), math.log(DT_MAX)),
        'ssm_b_re': nrm(7, (L, 2, SSM_GROUPS, SSM_STATE, SSM_GROUP_DIM), (2 * SSM_GROUP_DIM) ** -0.5),
        'ssm_b_im': nrm(8, (L, 2, SSM_GROUPS, SSM_STATE, SSM_GROUP_DIM), (2 * SSM_GROUP_DIM) ** -0.5),
        'ssm_c_re': nrm(9, (L, 2, SSM_GROUPS, SSM_GROUP_DIM, SSM_STATE), 2 ** -0.5),
        'ssm_c_im': nrm(10, (L, 2, SSM_GROUPS, SSM_GROUP_DIM, SSM_STATE), 2 ** -0.5),
        'ssm_d': nrm(11, (L, SSM_WIDTH), 1.0),
        'w_glu': nrm(12, (L, SSM_WIDTH, SSM_WIDTH), SSM_WIDTH ** -0.5),
        'w_br_fn': nrm(13, (L, FN_WIDTH, D_MODEL), FN_WIDTH ** -0.5),
        'w_br_na': nrm(14, (L, NA_WIDTH, D_MODEL), NA_WIDTH ** -0.5),
        'w_br_ssm': nrm(15, (L, SSM_WIDTH, D_MODEL), SSM_WIDTH ** -0.5),
        'w_out': nrm(16, (L, D_MODEL, D_MODEL), D_MODEL ** -0.5),
        'g_ffn': 1.0 + nrm(17, (L, D_MODEL), 0.01),
        'w_up': nrm(18, (L, D_MODEL, D_FF), D_MODEL ** -0.5),
        'w_down': nrm(19, (L, D_FF, D_MODEL), D_FF ** -0.5),
        'g_final': 1.0 + nrm(20, (D_MODEL,), 0.01),
    }


def reference(x, g_mix, w_in, na_rpb, ssm_a_re, ssm_a_im, ssm_log_dt, ssm_b_re, ssm_b_im,
              ssm_c_re, ssm_c_im, ssm_d, w_glu, w_br_fn, w_br_na, w_br_ssm, w_out,
              g_ffn, w_up, w_down, g_final):
    b, s, _ = x.shape
    splits = [FN_WIDTH, FN_WIDTH + NA_WIDTH, FN_WIDTH + 2 * NA_WIDTH,
              FN_WIDTH + 3 * NA_WIDTH, FN_WIDTH + 3 * NA_WIDTH + SSM_WIDTH]
    q_scale = NA_HEAD_DIM ** -0.5
    for l in range(DEPTH):
        h = rms_norm(x, g_mix[l])
        z = h @ w_in[l]
        u_fn, q, k, v, u_ssm, gate_logits = jnp.split(z, splits, axis=-1)
        gates = jax.nn.sigmoid(gate_logits.reshape(b, s, N_BRANCH, D_MODEL))
        y_fn = fourier_mix(u_fn) @ w_br_fn[l]
        y_na = neighbourhood_attention(q * q_scale, k, v, na_rpb[l]) @ w_br_na[l]
        y_ssm = ssm_branch(u_ssm, ssm_a_re[l], ssm_a_im[l], ssm_log_dt[l], ssm_b_re[l], ssm_b_im[l],
                           ssm_c_re[l], ssm_c_im[l], ssm_d[l], w_glu[l]) @ w_br_ssm[l]
        merged = gates[:, :, 0] * y_fn + gates[:, :, 1] * y_na + gates[:, :, 2] * y_ssm
        x = x + merged @ w_out[l]
        h = rms_norm(x, g_ffn[l])
        x = x + jnp.square(jax.nn.relu(h @ w_up[l])) @ w_down[l]
    return rms_norm(x, g_final)
```

```cpp
#include <hip/hip_runtime.h>
#include <hip/hip_cooperative_groups.h>
#include <cstdio>
namespace cg = cooperative_groups;

#ifndef FC_NOSTORE
#define FC_NOSTORE 0
#endif
#ifndef LDS_CLEAR
#define LDS_CLEAR 0
#endif
#ifndef SAFE_VM
#define SAFE_VM 0
#endif
#ifndef GCONST
#define GCONST 0
#endif
#ifndef PER_PHASE_LAUNCH
#define PER_PHASE_LAUNCH 0
#endif

#define LAS __attribute__((address_space(3)))
typedef unsigned short bf16_t;
typedef short bf16x8 __attribute__((ext_vector_type(8)));
typedef float f32x4 __attribute__((ext_vector_type(4)));
typedef float f32x2 __attribute__((ext_vector_type(2)));
typedef unsigned u32x4 __attribute__((ext_vector_type(4)));
typedef unsigned u32x2 __attribute__((ext_vector_type(2)));

constexpr int NTOK = 32768, DM = 1024, DFF = 4096, SEQ = 8192, NLAYER = 4;
constexpr size_t MiB = 1ull << 20;
constexpr size_t WS_H = 0;
constexpr size_t WS_T = 64 * MiB;
constexpr size_t WS_R1 = 128 * MiB;
constexpr size_t R1_Q = WS_R1, R1_K = WS_R1 + 32 * MiB, R1_VT = WS_R1 + 64 * MiB, R1_FA = WS_R1 + 96 * MiB, R1_FAF = WS_R1 + 112 * MiB,
                 R1_RF = WS_R1 + 120 * MiB, R1_SA = WS_R1 + 152 * MiB, R1_XLOC = WS_R1 + 184 * MiB, R1_YG = WS_R1 + 216 * MiB, R1_EXTRA = WS_R1 + 232 * MiB;
constexpr size_t R1_G = WS_R1, R1_HID = WS_R1;
constexpr size_t WS_OUTFN = 384 * MiB, WS_OUTNA = 400 * MiB, WS_OUTSSM = 432 * MiB;
constexpr size_t WS_W = 448 * MiB;
constexpr size_t W_IN = WS_W, W_BRFN = WS_W + 10 * MiB, W_BRNA = W_BRFN + MiB / 2, W_BRSSM = W_BRNA + MiB, W_OUT = WS_W + 12 * MiB, W_UP = WS_W + 14 * MiB,
                 W_DOWN = WS_W + 22 * MiB, W_GLU = WS_W + 30 * MiB, W_BT1 = W_GLU + MiB / 2, W_BT2 = W_BT1 + 2 * MiB;
constexpr size_t WS_LP = 485 * MiB;
constexpr size_t WS_BB = WS_LP + 5 * MiB / 4;
constexpr size_t WS_KT = WS_BB + MiB;
constexpr size_t WS_BAR = WS_KT + 2 * MiB;
constexpr size_t WS_END = WS_BAR + 4096;

struct Params {
    const float* in[21];
    float* out; unsigned char* ws;
    int ph_lo, ph_hi;
};

typedef __bf16 bf16x2_t __attribute__((ext_vector_type(2)));
__device__ __forceinline__ unsigned cvt_pk_bf16(float lo, float hi) { const f32x2 v = {lo, hi}; const bf16x2_t r = __builtin_convertvector(v, bf16x2_t); return __builtin_bit_cast(unsigned, r); }
__device__ __forceinline__ bf16_t f2bf(float v) { return (bf16_t)(cvt_pk_bf16(v, 0.f) & 0xffffu); }
__device__ __forceinline__ float bf2f(bf16_t b) { return __uint_as_float(((unsigned)b) << 16); }
__device__ __forceinline__ float bflo(unsigned w) { return __uint_as_float(w << 16); }
__device__ __forceinline__ float bfhi(unsigned w) { return __uint_as_float(w & 0xffff0000u); }
__device__ __forceinline__ float sigmoidf_(float x) { return __builtin_amdgcn_rcpf(1.0f + __expf(-x)); }
__device__ __forceinline__ float gelu_tanh(float x) { const float u = 0.7978845608028654f * (x + 0.044715f * x * x * x); return x * sigmoidf_(2.0f * u); }
__device__ __forceinline__ float wave_sum(float v) {
#pragma unroll
    for (int o = 1; o < 64; o <<= 1) v += __shfl_xor(v, o);
    return v;
}
__device__ __forceinline__ u32x4 pack8(const f32x4 a, const f32x4 b) { u32x4 w; w.x = cvt_pk_bf16(a[0], a[1]); w.y = cvt_pk_bf16(a[2], a[3]); w.z = cvt_pk_bf16(b[0], b[1]); w.w = cvt_pk_bf16(b[2], b[3]); return w; }

constexpr int BM = 256, BK = 64, HALF = 128, HTB = HALF * BK * 2, STAGE_BYTES = 8 * HTB, NXCD = 8, WGM = 8;
__device__ __forceinline__ int lds_byte(int r, int c) { const int st = (r >> 4) * 2 + (c >> 5), rr = r & 15, cc = c & 31, ob = rr * 64 + cc * 2; return st * 1024 + (ob ^ (((ob >> 9) & 1) << 5)); }
__device__ __forceinline__ void stage_rc(int b, int& R, int& C) { const int st = b / 1024, sb = b % 1024, swz = sb ^ (((sb >> 9) & 1) << 5); R = (st >> 1) * 16 + swz / 64; C = (st & 1) * 32 + (swz % 64) / 2; }
__device__ __forceinline__ int perm32(int rho) { const int n = rho >> 4, i = rho & 15; return 8 * (i >> 2) + 4 * n + (i & 3); }

struct Unit { int pm, pn, ko, kh; };
struct Gemm { const bf16_t* A; const bf16_t* Bt; int K, lda, ldb; };

struct StaticOrder {
    int nM, nN, nwg, G, c;
    __device__ void init(int M, int N, int G_, int c_) { nM = M / BM; nN = N / BM; nwg = nM * nN; G = G_; c = c_; }
    __device__ bool next(int i, Unit& u) const {
        const long L = (long)i * G + c; if (L >= nwg) return false;
        int wgid = (int)L; { const int q = nwg / NXCD, r = nwg % NXCD, xcd = wgid % NXCD, off = wgid / NXCD; wgid = (xcd < r ? xcd * (q + 1) : r * (q + 1) + (xcd - r) * q) + off; }
        const int nig = WGM * nN, gid = wgid / nig, fm = gid * WGM, gsz = (nM - fm) < WGM ? (nM - fm) : WGM;
        u.pm = fm + ((wgid % nig) % gsz); u.pn = (wgid % nig) / gsz; u.ko = 0; u.kh = 0; return true;
    }
};
struct DiagOrder {
    int G, c;
    __device__ bool next(int i, Unit& u) const { const long L = (long)i * G + c; if (L >= 128) return false; u.pm = (int)L; u.pn = (int)L >> 3; u.ko = 0; u.kh = 0; return true; }
};
struct FourierOrder {
    int G, c;
    __device__ bool next(int i, Unit& u) const { const long L = (long)i * G + c; if (L >= 256) return false; const int l = (int)L; u.kh = l & 1; u.pm = (l >> 1) & 3; u.pn = l >> 3; u.ko = u.kh * 2048; return true; }
};

template <class Epi, class Sched>
__device__ __forceinline__ void gemm_phase(LAS unsigned char* lds, const Gemm g, const Sched& S, const Epi& E) {
    int tid = threadIdx.x; asm volatile("" : "+v"(tid));
    const int wid = __builtin_amdgcn_readfirstlane(tid >> 6), lane = tid & 63, wr = wid >> 2, wc = wid & 3, fr = lane & 15, fq = lane >> 4;
    int K = g.K; asm volatile("" : "+s"(K)); const int nt = K / BK;
    unsigned voffA[2], voffB[2];
#pragma unroll
    for (int i = 0; i < 2; ++i) { int R, C; stage_rc(tid * 16 + i * 8192, R, C); const int Rb = Epi::PERM ? ((R & ~31) + perm32(R & 31)) : R;
        voffA[i] = (unsigned)(R * g.lda + C) * 2u; voffB[i] = (unsigned)(Rb * g.ldb + C) * 2u; }
    const size_t kstep = (size_t)(BK * 2);
    const size_t hstepA = (size_t)HALF * g.lda * 2, hstepB = (size_t)HALF * g.ldb * 2;
    const size_t tstepA = 2 * hstepA, tstepB = 2 * hstepB;
    const unsigned ldsw = (unsigned)wid * 1024u;
    const int aoff = lds_byte(wr * 64 + fr, fq * 8), boff = lds_byte(wc * 32 + fr, fq * 8);
#define PG8_SA(b, h) (((b) * 2 + (h)) * HTB)
#define PG8_SB(b, h) ((4 + (b) * 2 + (h)) * HTB)
#define PG8_STAGE(bufoff, gbase, voff) do { _Pragma("unroll") for (int _i = 0; _i < 2; ++_i) \
        __builtin_amdgcn_global_load_lds((const unsigned*)((const char*)(gbase) + (voff)[_i]), (LAS unsigned*)(lds + (bufoff) + ldsw + _i * 8192), 16, 0, 0); } while (0)
#define PG8_LDA(dst, b, h) do { _Pragma("unroll") for (int m = 0; m < 4; ++m) _Pragma("unroll") for (int k = 0; k < 2; ++k) dst[m][k] = *(const LAS bf16x8*)(lds + PG8_SA(b, h) + aoff + m * 2048 + k * 1024); } while (0)
#define PG8_LDB(dst, b, h) do { _Pragma("unroll") for (int n = 0; n < 2; ++n) _Pragma("unroll") for (int k = 0; k < 2; ++k) dst[n][k] = *(const LAS bf16x8*)(lds + PG8_SB(b, h) + boff + n * 2048 + k * 1024); } while (0)
#define PG8_MMA(ai, bj, At, Bt) do { __builtin_amdgcn_s_setprio(1); _Pragma("unroll") for (int m = 0; m < 4; ++m) _Pragma("unroll") for (int n = 0; n < 2; ++n) _Pragma("unroll") for (int k = 0; k < 2; ++k) \
        acc[ai][bj][m][n] = __builtin_amdgcn_mfma_f32_16x16x32_bf16(Bt[n][k], At[m][k], acc[ai][bj][m][n], 0, 0, 0); __builtin_amdgcn_s_setprio(0); } while (0)
#if SAFE_VM
#define PG8_WAIT_V(n) asm volatile("s_waitcnt vmcnt(0)" ::: "memory")
#else
#define PG8_WAIT_V(n) asm volatile("s_waitcnt vmcnt(" #n ")" ::: "memory")
#endif
#define PG8_WAIT_L(n) asm volatile("s_waitcnt lgkmcnt(" #n ")" ::: "memory")
#define PG8_BAR __builtin_amdgcn_s_barrier()
#define PG8_SCHED __builtin_amdgcn_sched_barrier(0)
    Unit cur, nxt; int ui = 0;
    if (!S.next(0, cur)) return;
    f32x4 acc[2][2][4][2];
#pragma unroll
    for (int a = 0; a < 2; ++a)
#pragma unroll
        for (int b = 0; b < 2; ++b)
#pragma unroll
            for (int m = 0; m < 4; ++m)
#pragma unroll
                for (int n = 0; n < 2; ++n) acc[a][b][m][n] = (f32x4){0.f, 0.f, 0.f, 0.f};
    bf16x8 At[4][2], B0[2][2], B1[2][2];
    const char* cA = (const char*)g.A + (size_t)cur.pm * tstepA + (size_t)cur.ko * 2; const char* cB = (const char*)g.Bt + (size_t)cur.pn * tstepB + (size_t)cur.ko * 2;
    PG8_STAGE(PG8_SB(0, 0), cB, voffB); PG8_STAGE(PG8_SA(0, 0), cA, voffA); PG8_STAGE(PG8_SB(0, 1), cB + hstepB, voffB); PG8_STAGE(PG8_SA(0, 1), cA + hstepA, voffA);
    if (wr == 1) PG8_BAR;
    PG8_WAIT_V(4); PG8_BAR;
    PG8_STAGE(PG8_SB(1, 0), cB + kstep, voffB); PG8_STAGE(PG8_SA(1, 0), cA + kstep, voffA); PG8_STAGE(PG8_SB(1, 1), cB + hstepB + kstep, voffB);
    PG8_WAIT_V(6); PG8_BAR;
    for (;;) {
        const bool has_next = S.next(ui + 1, nxt);
        const char* nA = has_next ? (const char*)g.A + (size_t)nxt.pm * tstepA + (size_t)nxt.ko * 2 : cA; const char* nB = has_next ? (const char*)g.Bt + (size_t)nxt.pn * tstepB + (size_t)nxt.ko * 2 : cB;
        for (int t = 0; t < nt; t += 2) {
            const bool last = (t == nt - 2);
            const char* a1 = cA + (size_t)(t + 1) * kstep;
            const char* a2 = last ? nA : cA + (size_t)(t + 2) * kstep; const char* b2 = last ? nB : cB + (size_t)(t + 2) * kstep;
            const char* a3 = a2 + kstep; const char* b3 = b2 + kstep;
            PG8_LDB(B0, 0, 0); PG8_SCHED; PG8_LDA(At, 0, 0); PG8_STAGE(PG8_SA(1, 1), a1 + hstepA, voffA);
            PG8_WAIT_L(8); PG8_BAR; PG8_WAIT_L(0); PG8_MMA(0, 0, At, B0); PG8_BAR; PG8_SCHED;
            PG8_LDB(B1, 0, 1); PG8_STAGE(PG8_SB(0, 0), b2, voffB);
            PG8_BAR; PG8_WAIT_L(0); PG8_MMA(0, 1, At, B1); PG8_BAR;
            PG8_LDA(At, 0, 1); PG8_STAGE(PG8_SA(0, 0), a2, voffA);
            PG8_BAR; PG8_WAIT_L(0); PG8_MMA(1, 0, At, B0); PG8_BAR; PG8_SCHED;
            PG8_STAGE(PG8_SB(0, 1), b2 + hstepB, voffB);
            PG8_WAIT_V(6); PG8_BAR; PG8_MMA(1, 1, At, B1); PG8_BAR;
            PG8_LDB(B0, 1, 0); PG8_SCHED; PG8_LDA(At, 1, 0); PG8_STAGE(PG8_SA(0, 1), a2 + hstepA, voffA);
            PG8_WAIT_L(8); PG8_BAR; PG8_WAIT_L(0); PG8_MMA(0, 0, At, B0); PG8_BAR; PG8_SCHED;
            PG8_LDB(B1, 1, 1); PG8_STAGE(PG8_SB(1, 0), b3, voffB);
            PG8_BAR; PG8_WAIT_L(0); PG8_MMA(0, 1, At, B1); PG8_BAR;
            PG8_LDA(At, 1, 1); PG8_STAGE(PG8_SA(1, 0), a3, voffA);
            PG8_BAR; PG8_WAIT_L(0); PG8_MMA(1, 0, At, B0); PG8_BAR; PG8_SCHED;
            PG8_STAGE(PG8_SB(1, 1), b3 + hstepB, voffB);
            PG8_WAIT_V(6); PG8_BAR; PG8_MMA(1, 1, At, B1); PG8_BAR;
        }
        { int fr_e = fr, fq_e = fq, wr_e = wr, wc_e = wc; asm volatile("" : "+v"(fr_e), "+v"(fq_e), "+s"(wr_e), "+s"(wc_e));
          E(acc, cur, wr_e, wc_e, fr_e, fq_e); }
        if (!has_next) break;
#pragma unroll
        for (int a = 0; a < 2; ++a)
#pragma unroll
            for (int b = 0; b < 2; ++b)
#pragma unroll
                for (int m = 0; m < 4; ++m)
#pragma unroll
                    for (int n = 0; n < 2; ++n) acc[a][b][m][n] = (f32x4){0.f, 0.f, 0.f, 0.f};
        cur = nxt; cA = nA; cB = nB; ++ui;
    }
    PG8_WAIT_V(0);
    if (wr == 0) PG8_BAR;
    PG8_BAR;
#undef PG8_SA
#undef PG8_SB
#undef PG8_STAGE
#undef PG8_LDA
#undef PG8_LDB
#undef PG8_MMA
#undef PG8_WAIT_V
#undef PG8_WAIT_L
#undef PG8_BAR
#undef PG8_SCHED
}

#define EPI_ARGS const f32x4 (&acc)[2][2][4][2], const Unit& u, int wr, int wc, int fr, int fq
#define FOR_AI_M _Pragma("unroll") for (int ai = 0; ai < 2; ++ai) _Pragma("unroll") for (int m = 0; m < 4; ++m) if ((__builtin_amdgcn_sched_barrier(0), true))

struct EpiZ {
    static constexpr bool PERM = true;
    bf16_t *Q, *Kb, *VT, *FA, *SA;
    __device__ __forceinline__ void operator()(EPI_ARGS) const {
        const int row0 = u.pm * BM + wr * 64 + fr, colt = wc * 32 + 8 * fq, pn = u.pn;
        if (pn == 0 || pn == 5 || pn == 6) {
            bf16_t* base = pn == 0 ? FA : VT; const int rpb = pn == 0 ? 256 : 512, coff = pn == 6 ? 256 : 0;
            FOR_AI_M { const int tok = row0 + ai * HALF + m * 16, b = tok >> 13, s = tok & 8191;
#pragma unroll
                for (int bj = 0; bj < 2; ++bj)
#pragma unroll
                    for (int n = 0; n < 2; ++n)
#pragma unroll
                        for (int j = 0; j < 4; ++j) { const int col = coff + bj * HALF + colt + 4 * n + j;
                            base[(size_t)(b * rpb + col) * 8192 + s] = f2bf(acc[ai][bj][m][n][j]); } }
        } else if (pn == 7) {
            FOR_AI_M { const int tok = row0 + ai * HALF + m * 16;
#pragma unroll
                for (int bj = 0; bj < 2; ++bj) { const int col = bj * HALF + colt, g = col >> 4, c = col & 15;
                    *(u32x4*)(SA + ((size_t)(g * 2048 + (tok >> 4)) * 512 + (tok & 15) * 16 + c)) = pack8(acc[ai][bj][m][0], acc[ai][bj][m][1]); } }
        } else {
            bf16_t* base = pn <= 2 ? Q : Kb; const int coff = ((pn - 1) & 1) * 256;
            FOR_AI_M { const int tok = row0 + ai * HALF + m * 16;
#pragma unroll
                for (int bj = 0; bj < 2; ++bj) *(u32x4*)(base + (size_t)tok * 512 + coff + bj * HALF + colt) = pack8(acc[ai][bj][m][0], acc[ai][bj][m][1]); }
        }
    }
};
struct EpiGate {
    static constexpr bool PERM = true;
    bf16_t* G;
    __device__ __forceinline__ void operator()(EPI_ARGS) const {
        const int row0 = u.pm * BM + wr * 64 + fr, colt = (u.pn & 3) * 256 + wc * 32 + 8 * fq;
        bf16_t* base = G + (size_t)(u.pn >> 2) * NTOK * 1024;
        FOR_AI_M { const int tok = row0 + ai * HALF + m * 16;
#pragma unroll
            for (int bj = 0; bj < 2; ++bj) { f32x4 a = acc[ai][bj][m][0], b = acc[ai][bj][m][1];
#pragma unroll
                for (int j = 0; j < 4; ++j) { a[j] = sigmoidf_(a[j]); b[j] = sigmoidf_(b[j]); }
                *(u32x4*)(base + (size_t)tok * 1024 + colt + bj * HALF) = pack8(a, b); } }
    }
};
struct EpiFour {
    static constexpr bool PERM = false;
    float* RF;
    __device__ __forceinline__ void operator()(EPI_ARGS) const {
        const int row0 = u.pm * BM + wr * 64 + fr, k0 = (u.pn & 15) * 256 + wc * 32 + 4 * fq; const bool cosTile = u.pn < 16;
        float* base = RF + (size_t)u.kh * 1024 * 4096;
        FOR_AI_M { const int row = row0 + ai * HALF + m * 16; const bool isP = (row & 63) <= 32;
            if (isP == cosTile) {
#pragma unroll
                for (int bj = 0; bj < 2; ++bj)
#pragma unroll
                    for (int n = 0; n < 2; ++n) *(f32x4*)(base + (size_t)row * 4096 + k0 + bj * HALF + n * 16) = acc[ai][bj][m][n]; } }
    }
};
struct EpiF32 {
    static constexpr bool PERM = false;
    float* C; int ldc;
    __device__ __forceinline__ void operator()(EPI_ARGS) const {
        const int row0 = u.pm * BM + wr * 64 + fr, col0 = wc * 32 + 4 * fq;
        FOR_AI_M { float* rowp = C + (size_t)(row0 + ai * HALF + m * 16) * ldc + col0;
#pragma unroll
            for (int bj = 0; bj < 2; ++bj)
#pragma unroll
                for (int n = 0; n < 2; ++n) *(f32x4*)(rowp + bj * HALF + n * 16) = acc[ai][bj][m][n]; }
    }
};
struct EpiSsmY {
    static constexpr bool PERM = true;
    bf16_t* YG;
    __device__ __forceinline__ void operator()(EPI_ARGS) const {
        const int row0 = u.pm * BM + wr * 64 + fr, colt = wc * 32 + 8 * fq;
        FOR_AI_M { const int row = row0 + ai * HALF + m * 16, g = row >> 11, t16 = row & 2047;
#pragma unroll
            for (int bj = 0; bj < 2; ++bj) { const int col = bj * HALF + colt, t = col >> 4, c0 = col & 15; f32x4 a = acc[ai][bj][m][0], b = acc[ai][bj][m][1];
#pragma unroll
                for (int j = 0; j < 4; ++j) { a[j] = gelu_tanh(a[j]); b[j] = gelu_tanh(b[j]); }
                *(u32x4*)(YG + (size_t)(t16 * 16 + t) * 256 + g * 16 + c0) = pack8(a, b); } }
    }
};
struct EpiGlu {
    static constexpr bool PERM = true;
    const bf16_t* YG; bf16_t* OUT;
    __device__ __forceinline__ void operator()(EPI_ARGS) const {
        const int row0 = u.pm * BM + wr * 64 + fr, colt = wc * 32 + 8 * fq;
        FOR_AI_M { const int tok = row0 + ai * HALF + m * 16;
#pragma unroll
            for (int bj = 0; bj < 2; ++bj) { const size_t o = (size_t)tok * 256 + colt + bj * HALF; const u32x4 y = *(const u32x4*)(YG + o);
                f32x4 a = acc[ai][bj][m][0], b = acc[ai][bj][m][1];
                a[0] = bflo(y.x) * sigmoidf_(a[0]); a[1] = bfhi(y.x) * sigmoidf_(a[1]); a[2] = bflo(y.y) * sigmoidf_(a[2]); a[3] = bfhi(y.y) * sigmoidf_(a[3]);
                b[0] = bflo(y.z) * sigmoidf_(b[0]); b[1] = bfhi(y.z) * sigmoidf_(b[1]); b[2] = bflo(y.w) * sigmoidf_(b[2]); b[3] = bfhi(y.w) * sigmoidf_(b[3]);
                *(u32x4*)(OUT + o) = pack8(a, b); } }
    }
};
template <bool FIRST> struct EpiMerge {
    static constexpr bool PERM = true;
    const bf16_t* G; bf16_t* MRG; float mul;
    __device__ __forceinline__ void operator()(EPI_ARGS) const {
        const int row0 = u.pm * BM + wr * 64 + fr, colt = u.pn * 256 + wc * 32 + 8 * fq;
        FOR_AI_M { const int tok = row0 + ai * HALF + m * 16;
#pragma unroll
            for (int bj = 0; bj < 2; ++bj) { const size_t o = (size_t)tok * 1024 + colt + bj * HALF; const u32x4 gq = *(const u32x4*)(G + o);
                f32x4 a = acc[ai][bj][m][0] * mul, b = acc[ai][bj][m][1] * mul;
                if (GCONST) { a = a * 0.5f; b = b * 0.5f; } else { a[0] *= bflo(gq.x); a[1] *= bfhi(gq.x); a[2] *= bflo(gq.y); a[3] *= bfhi(gq.y); b[0] *= bflo(gq.z); b[1] *= bfhi(gq.z); b[2] *= bflo(gq.w); b[3] *= bfhi(gq.w); }
                if (!FIRST) { const u32x4 o4 = *(const u32x4*)(MRG + o);
                    a[0] += bflo(o4.x); a[1] += bfhi(o4.x); a[2] += bflo(o4.y); a[3] += bfhi(o4.y); b[0] += bflo(o4.z); b[1] += bfhi(o4.z); b[2] += bflo(o4.w); b[3] += bfhi(o4.w); }
                *(u32x4*)(MRG + o) = pack8(a, b); } }
    }
};
struct EpiRes {
    static constexpr bool PERM = false;
    const float* src; float* dst;
    __device__ __forceinline__ void operator()(EPI_ARGS) const {
        const int row0 = u.pm * BM + wr * 64 + fr, col0 = u.pn * 256 + wc * 32 + 4 * fq;
        FOR_AI_M { const size_t ro = (size_t)(row0 + ai * HALF + m * 16) * 1024 + col0;
#pragma unroll
            for (int bj = 0; bj < 2; ++bj)
#pragma unroll
                for (int n = 0; n < 2; ++n) { const size_t o = ro + bj * HALF + n * 16; *(f32x4*)(dst + o) = *(const f32x4*)(src + o) + acc[ai][bj][m][n]; } }
    }
};
struct EpiUp {
    static constexpr bool PERM = true;
    bf16_t* HID;
    __device__ __forceinline__ void operator()(EPI_ARGS) const {
        const int row0 = u.pm * BM + wr * 64 + fr, colt = u.pn * 256 + wc * 32 + 8 * fq;
        FOR_AI_M { const int tok = row0 + ai * HALF + m * 16;
#pragma unroll
            for (int bj = 0; bj < 2; ++bj) { f32x4 a = acc[ai][bj][m][0], b = acc[ai][bj][m][1];
#pragma unroll
                for (int j = 0; j < 4; ++j) { const float x = fmaxf(a[j], 0.f), y = fmaxf(b[j], 0.f); a[j] = x * x; b[j] = y * y; }
                *(u32x4*)(HID + (size_t)tok * 4096 + colt + bj * HALF) = pack8(a, b); } }
    }
};

template <bool TO_BF16>
__device__ __forceinline__ void norm_row_out(const f32x4 (&v)[4], float ss, const float* gam, void* outp, int row, int lane) {
    const float rstd = rsqrtf(wave_sum(ss) * (1.0f / 1024.0f) + 1e-6f);
#pragma unroll
    for (int j = 0; j < 4; ++j) { const f32x4 gv = ((const f32x4*)gam)[lane + 64 * j]; const f32x4 y = v[j] * rstd * gv;
        if (TO_BF16) { u32x2 w; w.x = cvt_pk_bf16(y[0], y[1]); w.y = cvt_pk_bf16(y[2], y[3]); ((u32x2*)((bf16_t*)outp + (size_t)row * 1024))[lane + 64 * j] = w; }
        else ((f32x4*)((float*)outp + (size_t)row * 1024))[lane + 64 * j] = y; }
}
template <bool TO_BF16>
__device__ __forceinline__ void norm_phase(const float* x, const float* gam, void* outp, int gw, int ngw, int lane) {
    for (int row = gw; row < NTOK; row += 2 * ngw) {
        const int row2 = row + ngw; const bool has2 = row2 < NTOK;
        const f32x4* xr = (const f32x4*)(x + (size_t)row * 1024) + lane; const f32x4* xr2 = (const f32x4*)(x + (size_t)(has2 ? row2 : row) * 1024) + lane;
        f32x4 v[4], w[4]; float s = 0.f, s2 = 0.f;
#pragma unroll
        for (int j = 0; j < 4; ++j) { v[j] = xr[64 * j]; w[j] = xr2[64 * j]; }
#pragma unroll
        for (int j = 0; j < 4; ++j) { s += (v[j][0] * v[j][0] + v[j][1] * v[j][1]) + (v[j][2] * v[j][2] + v[j][3] * v[j][3]); s2 += (w[j][0] * w[j][0] + w[j][1] * w[j][1]) + (w[j][2] * w[j][2] + w[j][3] * w[j][3]); }
        norm_row_out<TO_BF16>(v, s, gam, outp, row, lane);
        if (has2) norm_row_out<TO_BF16>(w, s2, gam, outp, row2, lane);
    }
}

__device__ __forceinline__ void transpose_job(const float* W, int K, int ldw, int ncols, int c0, bf16_t* WT, int r0, float scale, LAS float* scr, int gw, int ngw, int lane) {
    const int nnb = ncols / 32, nitems = (K / 64) * nnb;
    for (int it = gw; it < nitems; it += ngw) {
        const int kb = it / nnb, nb = it % nnb, k0 = kb * 64, n0 = nb * 32;
#pragma unroll 8
        for (int i = 0; i < 32; ++i) { const int kk = 2 * i + (lane >> 5); scr[kk * 33 + (lane & 31)] = W[(size_t)(k0 + kk) * ldw + c0 + n0 + (lane & 31)]; }
        asm volatile("s_waitcnt lgkmcnt(0)" ::: "memory");
        const int c = lane & 7;
#pragma unroll
        for (int j = 0; j < 4; ++j) { const int n = (lane >> 3) + 8 * j; const LAS float* sp = scr + (8 * c) * 33 + n;
            u32x4 o; o.x = cvt_pk_bf16(sp[0] * scale, sp[33] * scale); o.y = cvt_pk_bf16(sp[66] * scale, sp[99] * scale); o.z = cvt_pk_bf16(sp[132] * scale, sp[165] * scale); o.w = cvt_pk_bf16(sp[198] * scale, sp[231] * scale);
            *(u32x4*)(WT + (size_t)(r0 + n0 + n) * K + k0 + 8 * c) = o; }
        asm volatile("s_waitcnt lgkmcnt(0)" ::: "memory");
    }
}

__device__ __forceinline__ void na_phase(const bf16_t* Q, const bf16_t* Kb, const bf16_t* VT, const LAS float* rpb, bf16_t* OUT, int gw, int ngw, int lane) {
    const int fr = lane & 15, fq = lane >> 4;
    for (int unit = gw; unit < 8192; unit += ngw) {
        const int j = unit & 3, rp = (unit >> 2) & 63, h = (unit >> 8) & 7, b = unit >> 11;
        const int r0 = rp * 2, r1 = r0 + 1;
        const int kra = min(max(r0 - 4, 0), 120), krb = min(max(r1 - 4, 0), 120), dsh = krb - kra, cs = min(max(16 * j - 8, 0), 32);
        const size_t tok0 = (size_t)b * 8192 + r0 * 64 + j * 16 + fr;
        const bf16_t* qp = Q + tok0 * 512 + h * 64 + fq * 8;
        const bf16x8 qa0 = *(const bf16x8*)qp, qa1 = *(const bf16x8*)(qp + 32), qb0 = *(const bf16x8*)(qp + 64 * 512), qb1 = *(const bf16x8*)(qp + 64 * 512 + 32);
        f32x4 sa[9][2], sb[9][2];
#pragma unroll
        for (int ub = 0; ub < 3; ++ub) {
            bf16x8 kf[3][2][2];
#pragma unroll
            for (int uu = 0; uu < 3; ++uu) { const int krow = min(kra + ub * 3 + uu, 127);
#pragma unroll
                for (int t = 0; t < 2; ++t) { const int kc = cs + (fr >> 2) * 8 + t * 4 + (fr & 3);
                    const bf16_t* kp = Kb + ((size_t)b * 8192 + krow * 64 + kc) * 512 + h * 64 + fq * 8; kf[uu][t][0] = *(const bf16x8*)kp; kf[uu][t][1] = *(const bf16x8*)(kp + 32); } }
            asm volatile("" ::: "memory");
#pragma unroll
            for (int uu = 0; uu < 3; ++uu)
#pragma unroll
                for (int t = 0; t < 2; ++t) { f32x4 a = (f32x4){0.f, 0.f, 0.f, 0.f}, c = (f32x4){0.f, 0.f, 0.f, 0.f};
                    a = __builtin_amdgcn_mfma_f32_16x16x32_bf16(kf[uu][t][0], qa0, a, 0, 0, 0); c = __builtin_amdgcn_mfma_f32_16x16x32_bf16(kf[uu][t][0], qb0, c, 0, 0, 0);
                    a = __builtin_amdgcn_mfma_f32_16x16x32_bf16(kf[uu][t][1], qa1, a, 0, 0, 0); c = __builtin_amdgcn_mfma_f32_16x16x32_bf16(kf[uu][t][1], qb1, c, 0, 0, 0);
                    sa[ub * 3 + uu][t] = a; sb[ub * 3 + uu][t] = c; }
        }
        const int qcol = 16 * j + fr, wsq = min(max(qcol - 8, 0), 48);
        const LAS float* bias_h = rpb + h * 15 * 31;
        float mxa = -1e30f, mxb = -1e30f;
#pragma unroll
        for (int u = 0; u < 9; ++u) { const int krow = kra + u; const bool va = u <= 7, vb = (u >= dsh) && (u <= 7 + dsh);
            const int dra = min(max(krow - r0 + 7, 0), 14), drb = min(max(krow - r1 + 7, 0), 14);
#pragma unroll
            for (int t = 0; t < 2; ++t)
#pragma unroll
                for (int jj = 0; jj < 4; ++jj) { const int kc = cs + fq * 8 + t * 4 + jj; const bool inw = (kc >= wsq) && (kc < wsq + 16); const int dc = min(max(kc - qcol, -15), 15) + 15;
                    const float xa = (va && inw) ? sa[u][t][jj] + bias_h[dra * 31 + dc] : -1e30f; const float xb = (vb && inw) ? sb[u][t][jj] + bias_h[drb * 31 + dc] : -1e30f;
                    sa[u][t][jj] = xa; sb[u][t][jj] = xb; mxa = fmaxf(mxa, xa); mxb = fmaxf(mxb, xb); } }
        mxa = fmaxf(mxa, __shfl_xor(mxa, 16)); mxa = fmaxf(mxa, __shfl_xor(mxa, 32)); mxb = fmaxf(mxb, __shfl_xor(mxb, 16)); mxb = fmaxf(mxb, __shfl_xor(mxb, 32));
        float suma = 0.f, sumb = 0.f;
#pragma unroll
        for (int u = 0; u < 9; ++u)
#pragma unroll
            for (int t = 0; t < 2; ++t)
#pragma unroll
                for (int jj = 0; jj < 4; ++jj) { const float xa = sa[u][t][jj], xb = sb[u][t][jj]; const float pa = xa > -1e29f ? __expf(xa - mxa) : 0.f, pb = xb > -1e29f ? __expf(xb - mxb) : 0.f;
                    sa[u][t][jj] = pa; sb[u][t][jj] = pb; suma += pa; sumb += pb; }
        suma += __shfl_xor(suma, 16); suma += __shfl_xor(suma, 32); sumb += __shfl_xor(sumb, 16); sumb += __shfl_xor(sumb, 32);
        f32x4 oa[4], ob[4];
#pragma unroll
        for (int dt = 0; dt < 4; ++dt) { oa[dt] = (f32x4){0.f, 0.f, 0.f, 0.f}; ob[dt] = (f32x4){0.f, 0.f, 0.f, 0.f}; }
#pragma unroll
        for (int ub = 0; ub < 3; ++ub) {
            bf16x8 vf[3][4];
#pragma unroll
            for (int uu = 0; uu < 3; ++uu) { const int krow = min(kra + ub * 3 + uu, 127);
#pragma unroll
                for (int dt = 0; dt < 4; ++dt) vf[uu][dt] = *(const bf16x8*)(VT + ((size_t)b * 512 + h * 64 + dt * 16 + fr) * 8192 + krow * 64 + cs + fq * 8); }
            asm volatile("" ::: "memory");
#pragma unroll
            for (int uu = 0; uu < 3; ++uu) { const int u = ub * 3 + uu;
                const bf16x8 pfa = __builtin_bit_cast(bf16x8, pack8(sa[u][0], sa[u][1])), pfb = __builtin_bit_cast(bf16x8, pack8(sb[u][0], sb[u][1]));
#pragma unroll
                for (int dt = 0; dt < 4; ++dt) { oa[dt] = __builtin_amdgcn_mfma_f32_16x16x32_bf16(vf[uu][dt], pfa, oa[dt], 0, 0, 0); ob[dt] = __builtin_amdgcn_mfma_f32_16x16x32_bf16(vf[uu][dt], pfb, ob[dt], 0, 0, 0); } }
        }
        const float inva = 1.0f / suma, invb = 1.0f / sumb;
#pragma unroll
        for (int dt = 0; dt < 4; ++dt) { u32x2 w; w.x = cvt_pk_bf16(oa[dt][0] * inva, oa[dt][1] * inva); w.y = cvt_pk_bf16(oa[dt][2] * inva, oa[dt][3] * inva);
            *(u32x2*)(OUT + tok0 * 512 + h * 64 + dt * 16 + 4 * fq) = w;
            u32x2 x; x.x = cvt_pk_bf16(ob[dt][0] * invb, ob[dt][1] * invb); x.y = cvt_pk_bf16(ob[dt][2] * invb, ob[dt][3] * invb);
            *(u32x2*)(OUT + (tok0 + 64) * 512 + h * 64 + dt * 16 + 4 * fq) = x; }
    }
}

__device__ __forceinline__ void fold_phase(const bf16_t* FA, bf16_t* FAF, float* EXTRA, int gw, int ngw, int lane) {
    const int hw = ngw >> 1;
    for (int row = gw - hw; row >= 0 && row < 1024; row += hw) {
        const bf16_t* src = FA + (size_t)row * 8192; bf16_t* dst = FAF + (size_t)row * 4096;
        const float sgn = ((row & 63) <= 32) ? 1.0f : -1.0f; float dot = 0.f;
        for (int it0 = 0; it0 < 64; it0 += 16) {
            bf16_t ra[16], rb[16];
#pragma unroll
            for (int e = 0; e < 16; ++e) { const int s = (it0 + e) * 64 + lane; ra[e] = src[s]; rb[e] = src[s ? 8192 - s : 0]; }
            asm volatile("" ::: "memory");
#pragma unroll
            for (int e = 0; e < 16; ++e) { const int s = (it0 + e) * 64 + lane; const float a = bf2f(ra[e]); const float bb = s ? bf2f(rb[e]) : 0.f;
                const float v = a + sgn * bb; dst[s] = f2bf(v); dot += (s & 1) ? -v : v; }
        }
        dot = wave_sum(dot); const float mid = bf2f(src[4096]);
        if (lane == 0) { EXTRA[32 * row] = mid; EXTRA[32 * row + 1] = dot + mid; }
    }
}
__device__ __forceinline__ void tgen_phase(bf16_t* T, int gt, int ngt) {
    for (int v = gt; v < 8192 * 512; v += ngt) { const int n = v >> 9, s0 = (v & 511) * 8, k = n & 4095; const bool isSin = n >= 4096; float e[8];
#pragma unroll
        for (int i = 0; i < 8; ++i) { const float f = (float)((k * (s0 + i)) & 8191) * (1.0f / 8192.0f); e[i] = isSin ? __builtin_amdgcn_sinf(f) : __builtin_amdgcn_cosf(f); }
        u32x4 w; w.x = cvt_pk_bf16(e[0], e[1]); w.y = cvt_pk_bf16(e[2], e[3]); w.z = cvt_pk_bf16(e[4], e[5]); w.w = cvt_pk_bf16(e[6], e[7]);
        *(u32x4*)(T + (size_t)v * 8) = w; }
}
__device__ __forceinline__ void fcombine_phase(const float* RF, const float* EXTRA, bf16_t* OUTFN, LAS float* tile, int blk, int nblk, int tid) {
    const float scale = 0.001381067932f;
    const bool deal = (nblk == 256); const int nmine = deal ? (blk < 128 ? 3 : 5) : (1024 - blk + nblk - 1) / nblk, tbase = deal ? (blk < 128 ? blk * 3 : 384 + (blk - 128) * 5) : blk;
    for (int q_ = 0; q_ < nmine; ++q_) { const int ti = deal ? tbase + q_ : tbase + q_ * nblk;
        const int kt = ti & 63, g = (ti >> 6) & 3, b = ti >> 8, rowb = b * 256 + g * 64;
#pragma unroll
        for (int i = 0; i < 8; ++i) { const int idx = tid + 512 * i, kk = idx & 63, jr = idx >> 6, row = rowb + jr; const size_t o = (size_t)row * 4096 + kt * 64 + kk;
            float v = RF[o] + RF[o + (size_t)1024 * 4096];
            if (jr <= 32) { const float e = EXTRA[32 * row]; v += (kk & 1) ? -e : e; }
            tile[jr * 65 + kk] = v; }
        __syncthreads();
#pragma unroll
        for (int i = 0; i < 16; ++i) { const int o = tid + 512 * i, m = o & 63, kk = (o >> 6) & 63, side = o >> 12, kp = kt * 64 + kk;
            const int mp = m <= 32 ? m : 64 - m; float sg = m <= 32 ? -1.f : 1.f; if (side) sg = -sg;
            float A = tile[mp * 65 + kk]; float B = (mp == 0 || mp == 32) ? 0.f : tile[(32 + mp) * 65 + kk];
            int k;
            if (side == 0) k = kp; else if (kp != 0) k = 8192 - kp; else { k = 4096; A = EXTRA[32 * (rowb + mp) + 1]; B = 0.f; }
            if (!FC_NOSTORE || A == 123456.789f) OUTFN[((size_t)b * 8192 + k) * 256 + g * 64 + m] = f2bf((A + sg * B) * scale); }
        __syncthreads();
    }
}

__device__ __forceinline__ void scan_phase(const float* XLOC, bf16_t* SA, const f32x2* LPl, LAS float* sh, int blk, int tid) {
    if (blk >= 128) return;
    const int d = blk & 1, g = (blk >> 1) & 15, b = blk >> 5, p = tid & 63, seg = tid >> 6;
    const f32x2 lt = LPl[(((size_t)d * 16 + g) * 64 + p) * 17 + 16];
    const size_t rowbase = (size_t)g * 2048 + b * 512;
    const float lr = lt[0], li = lt[1];
    float ar = 0.f, ai = 0.f;
    for (int i0 = 0; i0 < 64; i0 += 16) { float xr[16], xi[16];
#pragma unroll
        for (int e = 0; e < 16; ++e) { const int i = seg * 64 + i0 + e, ch = d ? 511 - i : i; const float* px = XLOC + (rowbase + ch) * 256 + d * 128 + p; xr[e] = px[0]; xi[e] = px[64]; }
#pragma unroll
        for (int e = 0; e < 16; ++e) { const float nr = lr * ar - li * ai + xr[e], ni = lr * ai + li * ar + xi[e]; ar = nr; ai = ni; } }
    sh[(seg * 64 + p) * 2] = ar; sh[(seg * 64 + p) * 2 + 1] = ai;
    __syncthreads();
    float l64r = lr, l64i = li;
#pragma unroll
    for (int q = 0; q < 6; ++q) { const float nr = l64r * l64r - l64i * l64i, ni = 2.f * l64r * l64i; l64r = nr; l64i = ni; }
    float Xr = 0.f, Xi = 0.f;
    for (int k = 0; k < seg; ++k) { const float sr = sh[(k * 64 + p) * 2], si = sh[(k * 64 + p) * 2 + 1]; const float nr = l64r * Xr - l64i * Xi + sr, ni = l64r * Xi + l64i * Xr + si; Xr = nr; Xi = ni; }
    for (int i0 = 0; i0 < 64; i0 += 16) { float xr[16], xi[16];
#pragma unroll
        for (int e = 0; e < 16; ++e) { const int i = seg * 64 + i0 + e, ch = d ? 511 - i : i; const float* px = XLOC + (rowbase + ch) * 256 + d * 128 + p; xr[e] = px[0]; xi[e] = px[64]; }
#pragma unroll
        for (int e = 0; e < 16; ++e) { const int i = seg * 64 + i0 + e, ch = d ? 511 - i : i; bf16_t* ps = SA + (rowbase + ch) * 512 + 256 + d * 128 + p;
            ps[0] = f2bf(Xr); ps[64] = f2bf(Xi);
            const float nr = lr * Xr - li * Xi + xr[e], ni = lr * Xi + li * Xr + xi[e]; Xr = nr; Xi = ni; } }
    __syncthreads();
}

__device__ __forceinline__ void ssm_prep_a(const float* log_dt, const float* a_re, const float* a_im, const float* b_re, const float* b_im, f32x2* LP, f32x2* BB, int gt, int ngt) {
    for (int i = gt; i < NLAYER * 2 * 16 * 64; i += ngt) {
        const int ldg = i >> 6;
        const double dt = (double)__expf(log_dt[ldg]);
        const double are = (double)a_re[i], aim = (double)a_im[i];
        const float mag = __expf((float)(are * dt));
        const double ang = aim * dt; const double rr = ang - 6.283185307179586 * rint(ang * 0.15915494309189535);
        const double q = rr * 0.125, q2 = q * q;
        double s = q * (1.0 - q2 / 6.0 * (1.0 - q2 / 20.0 * (1.0 - q2 / 42.0 * (1.0 - q2 / 72.0 * (1.0 - q2 / 110.0 * (1.0 - q2 / 156.0))))));
        double c = 1.0 - q2 / 2.0 * (1.0 - q2 / 12.0 * (1.0 - q2 / 30.0 * (1.0 - q2 / 56.0 * (1.0 - q2 / 90.0 * (1.0 - q2 / 132.0)))));
#pragma unroll
        for (int k = 0; k < 3; ++k) { const double s2 = 2.0 * s * c, c2 = 1.0 - 2.0 * s * s; s = s2; c = c2; }
        const double lbr = (double)mag * c, lbi = (double)mag * s;
        double pr = 1.0, pi = 0.0;
        for (int tau = 0; tau <= 16; ++tau) { LP[(size_t)i * 17 + tau] = (f32x2){(float)pr, (float)pi}; const double nr = pr * lbr - pi * lbi, ni = pr * lbi + pi * lbr; pr = nr; pi = ni; }
        const double nr_ = lbr - 1.0, ni_ = lbi, den = are * are + aim * aim; const double fr_ = (nr_ * are + ni_ * aim) / den, fi_ = (ni_ * are - nr_ * aim) / den;
        for (int c_ = 0; c_ < 16; ++c_) { const double br = (double)b_re[(size_t)i * 16 + c_], bi = (double)b_im[(size_t)i * 16 + c_];
            BB[(size_t)i * 16 + c_] = (f32x2){(float)(fr_ * br - fi_ * bi), (float)(fr_ * bi + fi_ * br)}; }
    }
}
__device__ __forceinline__ void ssm_prep_b(const float* c_re, const float* c_im, const f32x2* LP, const f32x2* BB, float* KT, int gt, int ngt) {
    for (int i = gt; i < NLAYER * 2 * 16 * 16 * 256; i += ngt) {
        const int cp = i & 15, c = (i >> 4) & 15, tau = (i >> 8) & 15, ldg = i >> 12;
        const float* cre = c_re + ((size_t)ldg * 16 + c) * 64; const float* cim = c_im + ((size_t)ldg * 16 + c) * 64;
        float accv = 0.f;
        for (int p = 0; p < 64; ++p) { const f32x2 l = LP[((size_t)ldg * 64 + p) * 17 + tau], bb = BB[((size_t)ldg * 64 + p) * 16 + cp];
            const float tr = l[0] * bb[0] - l[1] * bb[1], ti = l[0] * bb[1] + l[1] * bb[0]; accv += cre[p] * tr - cim[p] * ti; }
        KT[i] = accv;
    }
}
__device__ __forceinline__ void ssm_fill(const float* c_re, const float* c_im, const float* d_skip, int l, const f32x2* LP, const f32x2* BB, const float* KT, bf16_t* BT1, bf16_t* BT2, int gt, int ngt) {
    const f32x2* LPl = LP + (size_t)l * 2 * 16 * 64 * 17; const f32x2* BBl = BB + (size_t)l * 2 * 16 * 64 * 16; const float* KTl = KT + (size_t)l * 2 * 16 * 16 * 256;
    for (int i = gt; i < 16 * 256 * 256; i += ngt) {
        const int col = i & 255, jrow = (i >> 8) & 255, g = i >> 16, tp = col >> 4, cp = col & 15, d = jrow >> 7, p = jrow & 63; const bool im = (jrow & 64) != 0;
        const f32x2 lam = LPl[(((size_t)d * 16 + g) * 64 + p) * 17 + (d ? tp : 15 - tp)], bb = BBl[(((size_t)d * 16 + g) * 64 + p) * 16 + cp];
        BT1[i] = f2bf(im ? lam[0] * bb[1] + lam[1] * bb[0] : lam[0] * bb[0] - lam[1] * bb[1]);
    }
    const float* Dl = d_skip + (size_t)l * 256; const float* Cre = c_re + (size_t)l * 2 * 16 * 16 * 64; const float* Cim = c_im + (size_t)l * 2 * 16 * 16 * 64;
    for (int i = gt; i < 16 * 256 * 512; i += ngt) {
        const int col = i & 511, row = (i >> 9) & 255, g = i >> 17, t = row >> 4, c = row & 15; float v;
        if (col < 256) { const int tp = col >> 4, cp = col & 15, tau = t - tp;
            if (tau > 0) v = KTl[(((size_t)0 * 16 + g) * 16 + tau) * 256 + c * 16 + cp];
            else if (tau < 0) v = KTl[(((size_t)1 * 16 + g) * 16 - tau) * 256 + c * 16 + cp];
            else v = KTl[(((size_t)0 * 16 + g) * 16) * 256 + c * 16 + cp] + KTl[(((size_t)1 * 16 + g) * 16) * 256 + c * 16 + cp] + (c == cp ? Dl[g * 16 + c] : 0.f);
        } else { const int jc = col - 256, d = jc >> 7, p = jc & 63; const bool im = (jc & 64) != 0;
            const f32x2 lam = LPl[(((size_t)d * 16 + g) * 64 + p) * 17 + (d ? 16 - t : t + 1)];
            const float cr = Cre[(((size_t)d * 16 + g) * 16 + c) * 64 + p], ci = Cim[(((size_t)d * 16 + g) * 16 + c) * 64 + p];
            v = im ? -(cr * lam[1] + ci * lam[0]) : (cr * lam[0] - ci * lam[1]); }
        BT2[i] = f2bf(v);
    }
}
__device__ __forceinline__ void wfold_job(const float* Win, bf16_t* WT, int gt, int ngt) {
    for (int i = gt; i < 256 * 1024; i += ngt) { const int k = i & 1023, n = i >> 10, g = n >> 6, j = n & 63; const int mm = j <= 32 ? j : j - 32; const bool isSin = j > 32;
        const float* w = Win + (size_t)k * 5120 + g * 64; float a = 0.f;
        for (int c = 0; c < 64; ++c) { const float f = (float)((mm * c) & 63) * (1.0f / 64.0f); a += w[c] * (isSin ? __builtin_amdgcn_sinf(f) : __builtin_amdgcn_cosf(f)); }
        WT[(size_t)n * 1024 + k] = f2bf(a); }
}

#ifndef SUB3
#define SUB3 3
#endif
#ifndef SUB4
#define SUB4 3
#endif
#ifndef SUB6
#define SUB6 7
#endif
#ifndef FFN_ONLY
#define FFN_ONLY 0
#endif
#ifndef ZBR
#define ZBR 0
#endif
#ifndef SUBMASK
#define SUBMASK 0xff
#endif
#ifndef PHMASK
#define PHMASK 0xffff
#endif
constexpr int LDS_BYTES = STAGE_BYTES + 20480;
constexpr int PH_PER_LAYER = 11, PH_INIT = 2, PH_TOTAL = PH_INIT + NLAYER * PH_PER_LAYER + 1;

__global__ void __launch_bounds__(512, 2) fwd_megakernel(Params P) {
    extern __shared__ __attribute__((aligned(16))) unsigned char shm[];
    LAS unsigned char* lds = (LAS unsigned char*)shm;
    LAS float* ldsf = (LAS float*)(shm + STAGE_BYTES);
    cg::grid_group grid = cg::this_grid();
    const int blk = blockIdx.x, nblk = gridDim.x;
    const int ph_lo = P.ph_lo, ph_hi = P.ph_hi;
    grid.sync();
#define KA __attribute__((address_space(4)))
#define FRESH_IDS int tid = threadIdx.x; asm volatile("" : "+v"(tid)); const int lane = tid & 63, wave = tid >> 6, gw = blk * 8 + wave, ngw = nblk * 8, gt = blk * 512 + tid, ngt = nblk * 512; (void)lane; (void)gw; (void)ngw; (void)gt; (void)ngt;
#define WSP(T, off) ((T*)(ws + (off)))
    for (int ph = ph_lo; ph < ph_hi; ++ph) {
        const KA Params* kp = (const KA Params*)__builtin_amdgcn_kernarg_segment_ptr();
        asm volatile("" : "+s"(kp));
        unsigned char* ws = kp->ws;
        if (LDS_CLEAR) { int t_ = threadIdx.x; asm volatile("" : "+v"(t_)); for (int z = t_; z < STAGE_BYTES / 16; z += 512) ((LAS u32x4*)lds)[z] = (u32x4){0u, 0u, 0u, 0u}; __syncthreads(); }
        if (ph == 0) { if constexpr ((PHMASK >> 11) & 1) { FRESH_IDS; ssm_prep_a(kp->in[6], kp->in[4], kp->in[5], kp->in[7], kp->in[8], WSP(f32x2, WS_LP), WSP(f32x2, WS_BB), gt, ngt); } }
        else if (ph == 1) { if constexpr ((PHMASK >> 11) & 1) { FRESH_IDS; ssm_prep_b(kp->in[9], kp->in[10], WSP(f32x2, WS_LP), WSP(f32x2, WS_BB), WSP(float, WS_KT), gt, ngt); } }
        else if (ph == PH_TOTAL - 1) { FRESH_IDS; norm_phase<false>(kp->out, kp->in[20], kp->out, gw, ngw, lane); }
        else {
            const int l = (ph - PH_INIT) / PH_PER_LAYER, lp = (ph - PH_INIT) % PH_PER_LAYER;
            switch (lp) {
            case 0: if constexpr ((PHMASK >> 0) & 1) {
                const float* Win = kp->in[2] + (size_t)l * 1024 * 5120;
                { FRESH_IDS; LAS float* wscr = (LAS float*)(lds + wave * 16384);
                transpose_job(Win, 1024, 5120, 512, 256, WSP(bf16_t, W_IN), 256, 0.125f, wscr, gw, ngw, lane);
                transpose_job(Win, 1024, 5120, 4352, 768, WSP(bf16_t, W_IN), 768, 1.0f, wscr, gw, ngw, lane);
                transpose_job(kp->in[13] + (size_t)l * 256 * 1024, 256, 1024, 1024, 0, WSP(bf16_t, W_BRFN), 0, 1.0f, wscr, gw, ngw, lane);
                transpose_job(kp->in[14] + (size_t)l * 512 * 1024, 512, 1024, 1024, 0, WSP(bf16_t, W_BRNA), 0, 1.0f, wscr, gw, ngw, lane);
                transpose_job(kp->in[15] + (size_t)l * 256 * 1024, 256, 1024, 1024, 0, WSP(bf16_t, W_BRSSM), 0, 1.0f, wscr, gw, ngw, lane);
                transpose_job(kp->in[16] + (size_t)l * 1024 * 1024, 1024, 1024, 1024, 0, WSP(bf16_t, W_OUT), 0, 1.0f, wscr, gw, ngw, lane);
                transpose_job(kp->in[18] + (size_t)l * 1024 * 4096, 1024, 4096, 4096, 0, WSP(bf16_t, W_UP), 0, 1.0f, wscr, gw, ngw, lane);
                transpose_job(kp->in[19] + (size_t)l * 4096 * 1024, 4096, 1024, 1024, 0, WSP(bf16_t, W_DOWN), 0, 1.0f, wscr, gw, ngw, lane);
                transpose_job(kp->in[12] + (size_t)l * 256 * 256, 256, 256, 256, 0, WSP(bf16_t, W_GLU), 0, 1.0f, wscr, gw, ngw, lane);
                wfold_job(Win, WSP(bf16_t, W_IN), gt, ngt);
                ssm_fill(kp->in[9], kp->in[10], kp->in[11], l, WSP(f32x2, WS_LP), WSP(f32x2, WS_BB), WSP(float, WS_KT), WSP(bf16_t, W_BT1), WSP(bf16_t, W_BT2), gt, ngt);
                norm_phase<true>(l == 0 ? kp->in[0] : kp->out, kp->in[1] + (size_t)l * 1024, WSP(bf16_t, WS_H), gw, ngw, lane); }
            } break;
            case 1: if constexpr ((PHMASK >> 1) & 1) {
                StaticOrder S; S.init(NTOK, 2048, nblk, blk); EpiZ E{WSP(bf16_t, R1_Q), WSP(bf16_t, R1_K), WSP(bf16_t, R1_VT), WSP(bf16_t, R1_FA), WSP(bf16_t, R1_SA)};
                gemm_phase(lds, Gemm{WSP(bf16_t, WS_H), WSP(bf16_t, W_IN), 1024, 1024, 1024}, S, E);
            } break;
            case 2: if constexpr ((PHMASK >> 2) & 1) {
                if constexpr (SUBMASK & 1) { DiagOrder S{nblk, blk}; EpiF32 E{WSP(float, R1_XLOC), 256}; gemm_phase(lds, Gemm{WSP(bf16_t, R1_SA), WSP(bf16_t, W_BT1), 256, 512, 256}, S, E); }
                if constexpr (SUBMASK & 2) { FRESH_IDS; const float* rpbl = kp->in[3] + (size_t)l * 8 * 15 * 31;
                    for (int z = tid; z < 8 * 15 * 31; z += 512) ldsf[z] = rpbl[z];
                    __syncthreads();
                    na_phase(WSP(bf16_t, R1_Q), WSP(bf16_t, R1_K), WSP(bf16_t, R1_VT), ldsf, WSP(bf16_t, WS_OUTNA), gw, ngw, lane);
                    __syncthreads(); }
                if constexpr (SUBMASK & 4) { FRESH_IDS; fold_phase(WSP(bf16_t, R1_FA), WSP(bf16_t, R1_FAF), WSP(float, R1_EXTRA), gw, ngw, lane); }
                if constexpr (SUBMASK & 8) if (l == 0) { FRESH_IDS; tgen_phase(WSP(bf16_t, WS_T), gt, ngt); }
            } break;
            case 3: if constexpr ((PHMASK >> 3) & 1) {
                if constexpr (SUB3 & 1) { FourierOrder S{nblk, blk}; EpiFour E{WSP(float, R1_RF)}; gemm_phase(lds, Gemm{WSP(bf16_t, R1_FAF), WSP(bf16_t, WS_T), 2048, 4096, 4096}, S, E); }
                if constexpr (SUB3 & 2) { FRESH_IDS; scan_phase(WSP(float, R1_XLOC), WSP(bf16_t, R1_SA), WSP(f32x2, WS_LP) + (size_t)l * 2 * 16 * 64 * 17, ldsf, blk, tid); }
            } break;
            case 4: if constexpr ((PHMASK >> 4) & 1) {
                if constexpr (SUB4 & 1) { DiagOrder S{nblk, blk}; EpiSsmY E{WSP(bf16_t, R1_YG)}; gemm_phase(lds, Gemm{WSP(bf16_t, R1_SA), WSP(bf16_t, W_BT2), 512, 512, 512}, S, E); }
                if constexpr (SUB4 & 2) { FRESH_IDS; fcombine_phase(WSP(float, R1_RF), WSP(float, R1_EXTRA), WSP(bf16_t, WS_OUTFN), ldsf, blk, nblk, tid);
                    for (int z = tid; z < 64 * 65; z += 512) ldsf[z] = 0.f; __syncthreads(); }
            } break;
            case 5: if constexpr ((PHMASK >> 5) & 1) {
                if constexpr (SUBMASK & 1) { StaticOrder S; S.init(NTOK, 256, nblk, blk); EpiGlu E{WSP(bf16_t, R1_YG), WSP(bf16_t, WS_OUTSSM)}; gemm_phase(lds, Gemm{WSP(bf16_t, R1_YG), WSP(bf16_t, W_GLU), 256, 256, 256}, S, E); }
                if constexpr (SUBMASK & 2) { StaticOrder S; S.init(NTOK, 3072, nblk, blk); EpiGate E{WSP(bf16_t, R1_G)}; gemm_phase(lds, Gemm{WSP(bf16_t, WS_H), WSP(bf16_t, W_IN) + (size_t)2048 * 1024, 1024, 1024, 1024}, S, E); }
            } break;
            case 6: if constexpr ((PHMASK >> 6) & 1) {
                StaticOrder S; S.init(NTOK, 1024, nblk, blk);
                if constexpr (SUB6 & 1) { EpiMerge<true> E{WSP(bf16_t, R1_G), WSP(bf16_t, WS_H), (ZBR & 1) ? 0.f : 1.f}; gemm_phase(lds, Gemm{WSP(bf16_t, WS_OUTFN), WSP(bf16_t, W_BRFN), 256, 256, 256}, S, E); }
                if constexpr (SUB6 & 2) { EpiMerge<false> E{WSP(bf16_t, R1_G) + (size_t)NTOK * 1024, WSP(bf16_t, WS_H), (ZBR & 2) ? 0.f : 1.f}; gemm_phase(lds, Gemm{WSP(bf16_t, WS_OUTNA), WSP(bf16_t, W_BRNA), 512, 512, 512}, S, E); }
                if constexpr (SUB6 & 4) { EpiMerge<false> E{WSP(bf16_t, R1_G) + (size_t)2 * NTOK * 1024, WSP(bf16_t, WS_H), (ZBR & 4) ? 0.f : 1.f}; gemm_phase(lds, Gemm{WSP(bf16_t, WS_OUTSSM), WSP(bf16_t, W_BRSSM), 256, 256, 256}, S, E); }
            } break;
            case 7: if constexpr ((PHMASK >> 7) & 1) {
                StaticOrder S; S.init(NTOK, 1024, nblk, blk); EpiRes E{l == 0 ? kp->in[0] : kp->out, kp->out};
                gemm_phase(lds, Gemm{WSP(bf16_t, WS_H), WSP(bf16_t, W_OUT), 1024, 1024, 1024}, S, E);
            } break;
            case 8: if constexpr ((PHMASK >> 8) & 1) { FRESH_IDS; norm_phase<true>((FFN_ONLY && l == 0) ? kp->in[0] : kp->out, kp->in[17] + (size_t)l * 1024, WSP(bf16_t, WS_H), gw, ngw, lane); } break;
            case 9: if constexpr ((PHMASK >> 9) & 1) {
                StaticOrder S; S.init(NTOK, 4096, nblk, blk); EpiUp E{WSP(bf16_t, R1_HID)};
                gemm_phase(lds, Gemm{WSP(bf16_t, WS_H), WSP(bf16_t, W_UP), 1024, 1024, 1024}, S, E);
            } break;
            case 10: if constexpr ((PHMASK >> 10) & 1) {
                StaticOrder S; S.init(NTOK, 1024, nblk, blk); EpiRes E{(FFN_ONLY && l == 0) ? kp->in[0] : kp->out, kp->out};
                gemm_phase(lds, Gemm{WSP(bf16_t, R1_HID), WSP(bf16_t, W_DOWN), 4096, 4096, 4096}, S, E);
            } break;
            }
        }
        if (ph + 1 < ph_hi) {
            asm volatile("s_waitcnt vmcnt(0) lgkmcnt(0)" ::: "memory");
            __syncthreads();
            if (threadIdx.x == 0) {
                unsigned* bar = (unsigned*)(ws + WS_BAR);
                __builtin_amdgcn_fence(__ATOMIC_RELEASE, "agent"); asm volatile("s_waitcnt vmcnt(0)" ::: "memory");
                const unsigned k = (unsigned)(ph - ph_lo + 1), gsz = (unsigned)nblk >> 4;
                const unsigned old = __hip_atomic_fetch_add(bar + 16 * (1 + (blk & 15)), 1u, __ATOMIC_RELAXED, __HIP_MEMORY_SCOPE_AGENT);
                if (old + 1u == k * gsz) __hip_atomic_fetch_add(bar, 1u, __ATOMIC_RELAXED, __HIP_MEMORY_SCOPE_AGENT);
                while (__hip_atomic_load(bar, __ATOMIC_RELAXED, __HIP_MEMORY_SCOPE_AGENT) < k * 16u) __builtin_amdgcn_s_sleep(1);
            }
            __syncthreads();
            __builtin_amdgcn_fence(__ATOMIC_ACQUIRE, "agent");
            asm volatile("s_waitcnt vmcnt(0)" ::: "memory");
        }
    }
}

extern "C" void kernel_launch(void* const* d_in, const int* in_sizes, int n_in, void* d_out, int out_size, void* d_ws, size_t ws_size, hipStream_t stream) {
    static int grid_blocks = 0;
    if (!grid_blocks) {
        if (n_in != 21 || out_size != NTOK * DM || ws_size < WS_END) { fprintf(stderr, "kernel_launch: unexpected problem (n_in %d out %d ws %zu need %zu)\n", n_in, out_size, ws_size, (size_t)WS_END); grid_blocks = -1; return; }
        int dev = 0, cus = 0, per_cu = 0;
        hipGetDevice(&dev);
        hipDeviceGetAttribute(&cus, hipDeviceAttributeMultiprocessorCount, dev);
        if (hipFuncSetAttribute((const void*)fwd_megakernel, hipFuncAttributeMaxDynamicSharedMemorySize, LDS_BYTES) != hipSuccess) { fprintf(stderr, "kernel_launch: hipFuncSetAttribute failed\n"); grid_blocks = -1; return; }
        if (hipOccupancyMaxActiveBlocksPerMultiprocessor(&per_cu, (const void*)fwd_megakernel, 512, LDS_BYTES) != hipSuccess || per_cu < 1) { fprintf(stderr, "kernel_launch: occupancy query says %d\n", per_cu); per_cu = 1; }
        (void)hipGetLastError();
        grid_blocks = cus - (cus % 16);
    }
    if (grid_blocks < 0) return;
    Params p{};
    for (int i = 0; i < 21; ++i) p.in[i] = (const float*)d_in[i];
    p.out = (float*)d_out; p.ws = (unsigned char*)d_ws;
    if (hipMemsetAsync((unsigned char*)d_ws + WS_BAR, 0, 2048, stream) != hipSuccess) { fprintf(stderr, "kernel_launch: memset failed\n"); return; }
#if PER_PHASE_LAUNCH
    for (int ph = 0; ph < PH_TOTAL; ++ph) { p.ph_lo = ph; p.ph_hi = ph + 1; void* args[] = {&p};
        hipError_t e = hipLaunchCooperativeKernel((const void*)fwd_megakernel, dim3(grid_blocks), dim3(512), args, LDS_BYTES, stream);
        if (e != hipSuccess) { fprintf(stderr, "cooperative launch failed: %s (phase %d)\n", hipGetErrorString(e), ph); return; } }
#else
    p.ph_lo = 0; p.ph_hi = PH_TOTAL; void* args[] = {&p};
    hipError_t e = hipLaunchCooperativeKernel((const void*)fwd_megakernel, dim3(grid_blocks), dim3(512), args, LDS_BYTES, stream);
    if (e != hipSuccess) fprintf(stderr, "cooperative launch failed: %s (grid %d)\n", hipGetErrorString(e), grid_blocks);
#endif
}
```

```cpp
#include <hip/hip_runtime.h>
#include <hip/hip_cooperative_groups.h>
#include <cstdio>
namespace cg = cooperative_groups;

#ifndef FC_NOSTORE
#define FC_NOSTORE 0
#endif
#ifndef LDS_CLEAR
#define LDS_CLEAR 0
#endif
#ifndef SAFE_VM
#define SAFE_VM 0
#endif
#ifndef GCONST
#define GCONST 0
#endif
#ifndef PER_PHASE_LAUNCH
#define PER_PHASE_LAUNCH 0
#endif

#define LAS __attribute__((address_space(3)))
typedef unsigned short bf16_t;
typedef short bf16x8 __attribute__((ext_vector_type(8)));
typedef float f32x4 __attribute__((ext_vector_type(4)));
typedef float f32x2 __attribute__((ext_vector_type(2)));
typedef unsigned u32x4 __attribute__((ext_vector_type(4)));
typedef unsigned u32x2 __attribute__((ext_vector_type(2)));

constexpr int NTOK = 32768, DM = 1024, DFF = 4096, SEQ = 8192, NLAYER = 4;
constexpr size_t MiB = 1ull << 20;
constexpr size_t WS_H = 0;
constexpr size_t WS_T = 64 * MiB;
constexpr size_t WS_R1 = 128 * MiB;
constexpr size_t R1_Q = WS_R1, R1_K = WS_R1 + 32 * MiB, R1_VT = WS_R1 + 64 * MiB, R1_FA = WS_R1 + 96 * MiB, R1_FAF = WS_R1 + 112 * MiB,
                 R1_RF = WS_R1 + 120 * MiB, R1_SA = WS_R1 + 152 * MiB, R1_XLOC = WS_R1 + 184 * MiB, R1_YG = WS_R1 + 216 * MiB, R1_EXTRA = WS_R1 + 232 * MiB;
constexpr size_t R1_G = WS_R1, R1_HID = WS_R1;
constexpr size_t WS_OUTFN = 384 * MiB, WS_OUTNA = 400 * MiB, WS_OUTSSM = 432 * MiB;
constexpr size_t WS_W = 448 * MiB;
constexpr size_t W_IN = WS_W, W_BRFN = WS_W + 10 * MiB, W_BRNA = W_BRFN + MiB / 2, W_BRSSM = W_BRNA + MiB, W_OUT = WS_W + 12 * MiB, W_UP = WS_W + 14 * MiB,
                 W_DOWN = WS_W + 22 * MiB, W_GLU = WS_W + 30 * MiB, W_BT1 = W_GLU + MiB / 2, W_BT2 = W_BT1 + 2 * MiB;
constexpr size_t WS_LP = 485 * MiB;
constexpr size_t WS_BB = WS_LP + 5 * MiB / 4;
constexpr size_t WS_KT = WS_BB + MiB;
constexpr size_t WS_BAR = WS_KT + 2 * MiB;
constexpr size_t WS_END = WS_BAR + 4096;

struct Params {
    const float* in[21];
    float* out; unsigned char* ws;
    int ph_lo, ph_hi;
};

typedef __bf16 bf16x2_t __attribute__((ext_vector_type(2)));
__device__ __forceinline__ unsigned cvt_pk_bf16(float lo, float hi) { const f32x2 v = {lo, hi}; const bf16x2_t r = __builtin_convertvector(v, bf16x2_t); return __builtin_bit_cast(unsigned, r); }
__device__ __forceinline__ bf16_t f2bf(float v) { return (bf16_t)(cvt_pk_bf16(v, 0.f) & 0xffffu); }
__device__ __forceinline__ float bf2f(bf16_t b) { return __uint_as_float(((unsigned)b) << 16); }
__device__ __forceinline__ float bflo(unsigned w) { return __uint_as_float(w << 16); }
__device__ __forceinline__ float bfhi(unsigned w) { return __uint_as_float(w & 0xffff0000u); }
__device__ __forceinline__ float sigmoidf_(float x) { return __builtin_amdgcn_rcpf(1.0f + __expf(-x)); }
__device__ __forceinline__ float gelu_tanh(float x) { const float u = 0.7978845608028654f * (x + 0.044715f * x * x * x); return x * sigmoidf_(2.0f * u); }
__device__ __forceinline__ float wave_sum(float v) {
#pragma unroll
    for (int o = 1; o < 64; o <<= 1) v += __shfl_xor(v, o);
    return v;
}
__device__ __forceinline__ u32x4 pack8(const f32x4 a, const f32x4 b) { u32x4 w; w.x = cvt_pk_bf16(a[0], a[1]); w.y = cvt_pk_bf16(a[2], a[3]); w.z = cvt_pk_bf16(b[0], b[1]); w.w = cvt_pk_bf16(b[2], b[3]); return w; }

constexpr int BM = 256, BK = 64, HALF = 128, HTB = HALF * BK * 2, STAGE_BYTES = 8 * HTB, NXCD = 8, WGM = 8;
__device__ __forceinline__ int lds_byte(int r, int c) { const int st = (r >> 4) * 2 + (c >> 5), rr = r & 15, cc = c & 31, ob = rr * 64 + cc * 2; return st * 1024 + (ob ^ (((ob >> 9) & 1) << 5)); }
__device__ __forceinline__ void stage_rc(int b, int& R, int& C) { const int st = b / 1024, sb = b % 1024, swz = sb ^ (((sb >> 9) & 1) << 5); R = (st >> 1) * 16 + swz / 64; C = (st & 1) * 32 + (swz % 64) / 2; }
__device__ __forceinline__ int perm32(int rho) { const int n = rho >> 4, i = rho & 15; return 8 * (i >> 2) + 4 * n + (i & 3); }

struct Unit { int pm, pn, ko, kh; };
struct Gemm { const bf16_t* A; const bf16_t* Bt; int K, lda, ldb; };

struct StaticOrder {
    int nM, nN, nwg, G, c;
    __device__ void init(int M, int N, int G_, int c_) { nM = M / BM; nN = N / BM; nwg = nM * nN; G = G_; c = c_; }
    __device__ bool next(int i, Unit& u) const {
        const long L = (long)i * G + c; if (L >= nwg) return false;
        int wgid = (int)L; { const int q = nwg / NXCD, r = nwg % NXCD, xcd = wgid % NXCD, off = wgid / NXCD; wgid = (xcd < r ? xcd * (q + 1) : r * (q + 1) + (xcd - r) * q) + off; }
        const int nig = WGM * nN, gid = wgid / nig, fm = gid * WGM, gsz = (nM - fm) < WGM ? (nM - fm) : WGM;
        u.pm = fm + ((wgid % nig) % gsz); u.pn = (wgid % nig) / gsz; u.ko = 0; u.kh = 0; return true;
    }
};
struct DiagOrder {
    int G, c;
    __device__ bool next(int i, Unit& u) const { const long L = (long)i * G + c; if (L >= 128) return false; u.pm = (int)L; u.pn = (int)L >> 3; u.ko = 0; u.kh = 0; return true; }
};
struct FourierOrder {
    int G, c;
    __device__ bool next(int i, Unit& u) const { const long L = (long)i * G + c; if (L >= 256) return false; const int l = (int)L; u.kh = l & 1; u.pm = (l >> 1) & 3; u.pn = l >> 3; u.ko = u.kh * 2048; return true; }
};

template <class Epi, class Sched>
__device__ __forceinline__ void gemm_phase(LAS unsigned char* lds, const Gemm g, const Sched& S, const Epi& E) {
    int tid = threadIdx.x; asm volatile("" : "+v"(tid));
    const int wid = __builtin_amdgcn_readfirstlane(tid >> 6), lane = tid & 63, wr = wid >> 2, wc = wid & 3, fr = lane & 15, fq = lane >> 4;
    int K = g.K; asm volatile("" : "+s"(K)); const int nt = K / BK;
    unsigned voffA[2], voffB[2];
#pragma unroll
    for (int i = 0; i < 2; ++i) { int R, C; stage_rc(tid * 16 + i * 8192, R, C); const int Rb = Epi::PERM ? ((R & ~31) + perm32(R & 31)) : R;
        voffA[i] = (unsigned)(R * g.lda + C) * 2u; voffB[i] = (unsigned)(Rb * g.ldb + C) * 2u; }
    const size_t kstep = (size_t)(BK * 2);
    const size_t hstepA = (size_t)HALF * g.lda * 2, hstepB = (size_t)HALF * g.ldb * 2;
    const size_t tstepA = 2 * hstepA, tstepB = 2 * hstepB;
    const unsigned ldsw = (unsigned)wid * 1024u;
    const int aoff = lds_byte(wr * 64 + fr, fq * 8), boff = lds_byte(wc * 32 + fr, fq * 8);
#define PG8_SA(b, h) (((b) * 2 + (h)) * HTB)
#define PG8_SB(b, h) ((4 + (b) * 2 + (h)) * HTB)
#define PG8_STAGE(bufoff, gbase, voff) do { _Pragma("unroll") for (int _i = 0; _i < 2; ++_i) \
        __builtin_amdgcn_global_load_lds((const unsigned*)((const char*)(gbase) + (voff)[_i]), (LAS unsigned*)(lds + (bufoff) + ldsw + _i * 8192), 16, 0, 0); } while (0)
#define PG8_LDA(dst, b, h) do { _Pragma("unroll") for (int m = 0; m < 4; ++m) _Pragma("unroll") for (int k = 0; k < 2; ++k) dst[m][k] = *(const LAS bf16x8*)(lds + PG8_SA(b, h) + aoff + m * 2048 + k * 1024); } while (0)
#define PG8_LDB(dst, b, h) do { _Pragma("unroll") for (int n = 0; n < 2; ++n) _Pragma("unroll") for (int k = 0; k < 2; ++k) dst[n][k] = *(const LAS bf16x8*)(lds + PG8_SB(b, h) + boff + n * 2048 + k * 1024); } while (0)
#define PG8_MMA(ai, bj, At, Bt) do { __builtin_amdgcn_s_setprio(1); _Pragma("unroll") for (int m = 0; m < 4; ++m) _Pragma("unroll") for (int n = 0; n < 2; ++n) _Pragma("unroll") for (int k = 0; k < 2; ++k) \
        acc[ai][bj][m][n] = __builtin_amdgcn_mfma_f32_16x16x32_bf16(Bt[n][k], At[m][k], acc[ai][bj][m][n], 0, 0, 0); __builtin_amdgcn_s_setprio(0); } while (0)
#if SAFE_VM
#define PG8_WAIT_V(n) asm volatile("s_waitcnt vmcnt(0)" ::: "memory")
#else
#define PG8_WAIT_V(n) asm volatile("s_waitcnt vmcnt(" #n ")" ::: "memory")
#endif
#define PG8_WAIT_L(n) asm volatile("s_waitcnt lgkmcnt(" #n ")" ::: "memory")
#define PG8_BAR __builtin_amdgcn_s_barrier()
#define PG8_SCHED __builtin_amdgcn_sched_barrier(0)
    Unit cur, nxt; int ui = 0;
    if (!S.next(0, cur)) return;
    f32x4 acc[2][2][4][2];
#pragma unroll
    for (int a = 0; a < 2; ++a)
#pragma unroll
        for (int b = 0; b < 2; ++b)
#pragma unroll
            for (int m = 0; m < 4; ++m)
#pragma unroll
                for (int n = 0; n < 2; ++n) acc[a][b][m][n] = (f32x4){0.f, 0.f, 0.f, 0.f};
    bf16x8 At[4][2], B0[2][2], B1[2][2];
    const char* cA = (const char*)g.A + (size_t)cur.pm * tstepA + (size_t)cur.ko * 2; const char* cB = (const char*)g.Bt + (size_t)cur.pn * tstepB + (size_t)cur.ko * 2;
    PG8_STAGE(PG8_SB(0, 0), cB, voffB); PG8_STAGE(PG8_SA(0, 0), cA, voffA); PG8_STAGE(PG8_SB(0, 1), cB + hstepB, voffB); PG8_STAGE(PG8_SA(0, 1), cA + hstepA, voffA);
    if (wr == 1) PG8_BAR;
    PG8_WAIT_V(4); PG8_BAR;
    PG8_STAGE(PG8_SB(1, 0), cB + kstep, voffB); PG8_STAGE(PG8_SA(1, 0), cA + kstep, voffA); PG8_STAGE(PG8_SB(1, 1), cB + hstepB + kstep, voffB);
    PG8_WAIT_V(6); PG8_BAR;
    for (;;) {
        const bool has_next = S.next(ui + 1, nxt);
        const char* nA = has_next ? (const char*)g.A + (size_t)nxt.pm * tstepA + (size_t)nxt.ko * 2 : cA; const char* nB = has_next ? (const char*)g.Bt + (size_t)nxt.pn * tstepB + (size_t)nxt.ko * 2 : cB;
        for (int t = 0; t < nt; t += 2) {
            const bool last = (t == nt - 2);
            const char* a1 = cA + (size_t)(t + 1) * kstep;
            const char* a2 = last ? nA : cA + (size_t)(t + 2) * kstep; const char* b2 = last ? nB : cB + (size_t)(t + 2) * kstep;
            const char* a3 = a2 + kstep; const char* b3 = b2 + kstep;
            PG8_LDB(B0, 0, 0); PG8_SCHED; PG8_LDA(At, 0, 0); PG8_STAGE(PG8_SA(1, 1), a1 + hstepA, voffA);
            PG8_WAIT_L(8); PG8_BAR; PG8_WAIT_L(0); PG8_MMA(0, 0, At, B0); PG8_BAR; PG8_SCHED;
            PG8_LDB(B1, 0, 1); PG8_STAGE(PG8_SB(0, 0), b2, voffB);
            PG8_BAR; PG8_WAIT_L(0); PG8_MMA(0, 1, At, B1); PG8_BAR;
            PG8_LDA(At, 0, 1); PG8_STAGE(PG8_SA(0, 0), a2, voffA);
            PG8_BAR; PG8_WAIT_L(0); PG8_MMA(1, 0, At, B0); PG8_BAR; PG8_SCHED;
            PG8_STAGE(PG8_SB(0, 1), b2 + hstepB, voffB);
            PG8_WAIT_V(6); PG8_BAR; PG8_MMA(1, 1, At, B1); PG8_BAR;
            PG8_LDB(B0, 1, 0); PG8_SCHED; PG8_LDA(At, 1, 0); PG8_STAGE(PG8_SA(0, 1), a2 + hstepA, voffA);
            PG8_WAIT_L(8); PG8_BAR; PG8_WAIT_L(0); PG8_MMA(0, 0, At, B0); PG8_BAR; PG8_SCHED;
            PG8_LDB(B1, 1, 1); PG8_STAGE(PG8_SB(1, 0), b3, voffB);
            PG8_BAR; PG8_WAIT_L(0); PG8_MMA(0, 1, At, B1); PG8_BAR;
            PG8_LDA(At, 1, 1); PG8_STAGE(PG8_SA(1, 0), a3, voffA);
            PG8_BAR; PG8_WAIT_L(0); PG8_MMA(1, 0, At, B0); PG8_BAR; PG8_SCHED;
            PG8_STAGE(PG8_SB(1, 1), b3 + hstepB, voffB);
            PG8_WAIT_V(6); PG8_BAR; PG8_MMA(1, 1, At, B1); PG8_BAR;
        }
        { int fr_e = fr, fq_e = fq, wr_e = wr, wc_e = wc; asm volatile("" : "+v"(fr_e), "+v"(fq_e), "+s"(wr_e), "+s"(wc_e));
          E(acc, cur, wr_e, wc_e, fr_e, fq_e); }
        if (!has_next) break;
#pragma unroll
        for (int a = 0; a < 2; ++a)
#pragma unroll
            for (int b = 0; b < 2; ++b)
#pragma unroll
                for (int m = 0; m < 4; ++m)
#pragma unroll
                    for (int n = 0; n < 2; ++n) acc[a][b][m][n] = (f32x4){0.f, 0.f, 0.f, 0.f};
        cur = nxt; cA = nA; cB = nB; ++ui;
    }
    PG8_WAIT_V(0);
    if (wr == 0) PG8_BAR;
    PG8_BAR;
#undef PG8_SA
#undef PG8_SB
#undef PG8_STAGE
#undef PG8_LDA
#undef PG8_LDB
#undef PG8_MMA
#undef PG8_WAIT_V
#undef PG8_WAIT_L
#undef PG8_BAR
#undef PG8_SCHED
}

#define EPI_ARGS const f32x4 (&acc)[2][2][4][2], const Unit& u, int wr, int wc, int fr, int fq
#define FOR_AI_M _Pragma("unroll") for (int ai = 0; ai < 2; ++ai) _Pragma("unroll") for (int m = 0; m < 4; ++m) if ((__builtin_amdgcn_sched_barrier(0), true))

struct EpiZ {
    static constexpr bool PERM = true;
    bf16_t *Q, *Kb, *VT, *FA, *SA;
    __device__ __forceinline__ void operator()(EPI_ARGS) const {
        const int row0 = u.pm * BM + wr * 64 + fr, colt = wc * 32 + 8 * fq, pn = u.pn;
        if (pn == 0 || pn == 5 || pn == 6) {
            bf16_t* base = pn == 0 ? FA : VT; const int rpb = pn == 0 ? 256 : 512, coff = pn == 6 ? 256 : 0;
            FOR_AI_M { const int tok = row0 + ai * HALF + m * 16, b = tok >> 13, s = tok & 8191;
#pragma unroll
                for (int bj = 0; bj < 2; ++bj)
#pragma unroll
                    for (int n = 0; n < 2; ++n)
#pragma unroll
                        for (int j = 0; j < 4; ++j) { const int col = coff + bj * HALF + colt + 4 * n + j;
                            base[(size_t)(b * rpb + col) * 8192 + s] = f2bf(acc[ai][bj][m][n][j]); } }
        } else if (pn == 7) {
            FOR_AI_M { const int tok = row0 + ai * HALF + m * 16;
#pragma unroll
                for (int bj = 0; bj < 2; ++bj) { const int col = bj * HALF + colt, g = col >> 4, c = col & 15;
                    *(u32x4*)(SA + ((size_t)(g * 2048 + (tok >> 4)) * 512 + (tok & 15) * 16 + c)) = pack8(acc[ai][bj][m][0], acc[ai][bj][m][1]); } }
        } else {
            bf16_t* base = pn <= 2 ? Q : Kb; const int coff = ((pn - 1) & 1) * 256;
            FOR_AI_M { const int tok = row0 + ai * HALF + m * 16;
#pragma unroll
                for (int bj = 0; bj < 2; ++bj) *(u32x4*)(base + (size_t)tok * 512 + coff + bj * HALF + colt) = pack8(acc[ai][bj][m][0], acc[ai][bj][m][1]); }
        }
    }
};
struct EpiGate {
    static constexpr bool PERM = true;
    bf16_t* G;
    __device__ __forceinline__ void operator()(EPI_ARGS) const {
        const int row0 = u.pm * BM + wr * 64 + fr, colt = (u.pn & 3) * 256 + wc * 32 + 8 * fq;
        bf16_t* base = G + (size_t)(u.pn >> 2) * NTOK * 1024;
        FOR_AI_M { const int tok = row0 + ai * HALF + m * 16;
#pragma unroll
            for (int bj = 0; bj < 2; ++bj) { f32x4 a = acc[ai][bj][m][0], b = acc[ai][bj][m][1];
#pragma unroll
                for (int j = 0; j < 4; ++j) { a[j] = sigmoidf_(a[j]); b[j] = sigmoidf_(b[j]); }
                *(u32x4*)(base + (size_t)tok * 1024 + colt + bj * HALF) = pack8(a, b); } }
    }
};
struct EpiFour {
    static constexpr bool PERM = false;
    float* RF;
    __device__ __forceinline__ void operator()(EPI_ARGS) const {
        const int row0 = u.pm * BM + wr * 64 + fr, k0 = (u.pn & 15) * 256 + wc * 32 + 4 * fq; const bool cosTile = u.pn < 16;
        float* base = RF + (size_t)u.kh * 1024 * 4096;
        FOR_AI_M { const int row = row0 + ai * HALF + m * 16; const bool isP = (row & 63) <= 32;
            if (isP == cosTile) {
#pragma unroll
                for (int bj = 0; bj < 2; ++bj)
#pragma unroll
                    for (int n = 0; n < 2; ++n) *(f32x4*)(base + (size_t)row * 4096 + k0 + bj * HALF + n * 16) = acc[ai][bj][m][n]; } }
    }
};
struct EpiF32 {
    static constexpr bool PERM = false;
    float* C; int ldc;
    __device__ __forceinline__ void operator()(EPI_ARGS) const {
        const int row0 = u.pm * BM + wr * 64 + fr, col0 = wc * 32 + 4 * fq;
        FOR_AI_M { float* rowp = C + (size_t)(row0 + ai * HALF + m * 16) * ldc + col0;
#pragma unroll
            for (int bj = 0; bj < 2; ++bj)
#pragma unroll
                for (int n = 0; n < 2; ++n) *(f32x4*)(rowp + bj * HALF + n * 16) = acc[ai][bj][m][n]; }
    }
};
struct EpiSsmY {
    static constexpr bool PERM = true;
    bf16_t* YG;
    __device__ __forceinline__ void operator()(EPI_ARGS) const {
        const int row0 = u.pm * BM + wr * 64 + fr, colt = wc * 32 + 8 * fq;
        FOR_AI_M { const int row = row0 + ai * HALF + m * 16, g = row >> 11, t16 = row & 2047;
#pragma unroll
            for (int bj = 0; bj < 2; ++bj) { const int col = bj * HALF + colt, t = col >> 4, c0 = col & 15; f32x4 a = acc[ai][bj][m][0], b = acc[ai][bj][m][1];
#pragma unroll
                for (int j = 0; j < 4; ++j) { a[j] = gelu_tanh(a[j]); b[j] = gelu_tanh(b[j]); }
                *(u32x4*)(YG + (size_t)(t16 * 16 + t) * 256 + g * 16 + c0) = pack8(a, b); } }
    }
};
struct EpiGlu {
    static constexpr bool PERM = true;
    const bf16_t* YG; bf16_t* OUT;
    __device__ __forceinline__ void operator()(EPI_ARGS) const {
        const int row0 = u.pm * BM + wr * 64 + fr, colt = wc * 32 + 8 * fq;
        FOR_AI_M { const int tok = row0 + ai * HALF + m * 16;
#pragma unroll
            for (int bj = 0; bj < 2; ++bj) { const size_t o = (size_t)tok * 256 + colt + bj * HALF; const u32x4 y = *(const u32x4*)(YG + o);
                f32x4 a = acc[ai][bj][m][0], b = acc[ai][bj][m][1];
                a[0] = bflo(y.x) * sigmoidf_(a[0]); a[1] = bfhi(y.x) * sigmoidf_(a[1]); a[2] = bflo(y.y) * sigmoidf_(a[2]); a[3] = bfhi(y.y) * sigmoidf_(a[3]);
                b[0] = bflo(y.z) * sigmoidf_(b[0]); b[1] = bfhi(y.z) * sigmoidf_(b[1]); b[2] = bflo(y.w) * sigmoidf_(b[2]); b[3] = bfhi(y.w) * sigmoidf_(b[3]);
                *(u32x4*)(OUT + o) = pack8(a, b); } }
    }
};
template <bool FIRST> struct EpiMerge {
    static constexpr bool PERM = true;
    const bf16_t* G; bf16_t* MRG; float mul;
    __device__ __forceinline__ void operator()(EPI_ARGS) const {
        const int row0 = u.pm * BM + wr * 64 + fr, colt = u.pn * 256 + wc * 32 + 8 * fq;
        FOR_AI_M { const int tok = row0 + ai * HALF + m * 16;
#pragma unroll
            for (int bj = 0; bj < 2; ++bj) { const size_t o = (size_t)tok * 1024 + colt + bj * HALF; const u32x4 gq = *(const u32x4*)(G + o);
                f32x4 a = acc[ai][bj][m][0] * mul, b = acc[ai][bj][m][1] * mul;
                if (GCONST) { a = a * 0.5f; b = b * 0.5f; } else { a[0] *= bflo(gq.x); a[1] *= bfhi(gq.x); a[2] *= bflo(gq.y); a[3] *= bfhi(gq.y); b[0] *= bflo(gq.z); b[1] *= bfhi(gq.z); b[2] *= bflo(gq.w); b[3] *= bfhi(gq.w); }
                if (!FIRST) { const u32x4 o4 = *(const u32x4*)(MRG + o);
                    a[0] += bflo(o4.x); a[1] += bfhi(o4.x); a[2] += bflo(o4.y); a[3] += bfhi(o4.y); b[0] += bflo(o4.z); b[1] += bfhi(o4.z); b[2] += bflo(o4.w); b[3] += bfhi(o4.w); }
                *(u32x4*)(MRG + o) = pack8(a, b); } }
    }
};
struct EpiRes {
    static constexpr bool PERM = false;
    const float* src; float* dst;
    __device__ __forceinline__ void operator()(EPI_ARGS) const {
        const int row0 = u.pm * BM + wr * 64 + fr, col0 = u.pn * 256 + wc * 32 + 4 * fq;
        FOR_AI_M { const size_t ro = (size_t)(row0 + ai * HALF + m * 16) * 1024 + col0;
#pragma unroll
            for (int bj = 0; bj < 2; ++bj)
#pragma unroll
                for (int n = 0; n < 2; ++n) { const size_t o = ro + bj * HALF + n * 16; *(f32x4*)(dst + o) = *(const f32x4*)(src + o) + acc[ai][bj][m][n]; } }
    }
};
struct EpiUp {
    static constexpr bool PERM = true;
    bf16_t* HID;
    __device__ __forceinline__ void operator()(EPI_ARGS) const {
        const int row0 = u.pm * BM + wr * 64 + fr, colt = u.pn * 256 + wc * 32 + 8 * fq;
        FOR_AI_M { const int tok = row0 + ai * HALF + m * 16;
#pragma unroll
            for (int bj = 0; bj < 2; ++bj) { f32x4 a = acc[ai][bj][m][0], b = acc[ai][bj][m][1];
#pragma unroll
                for (int j = 0; j < 4; ++j) { const float x = fmaxf(a[j], 0.f), y = fmaxf(b[j], 0.f); a[j] = x * x; b[j] = y * y; }
                *(u32x4*)(HID + (size_t)tok * 4096 + colt + bj * HALF) = pack8(a, b); } }
    }
};

template <bool TO_BF16>
__device__ __forceinline__ void norm_phase(const float* x, const float* gam, void* outp, int gw, int ngw, int lane) {
    for (int row = gw; row < NTOK; row += ngw) {
        const f32x4* xr = (const f32x4*)(x + (size_t)row * 1024) + lane;
        f32x4 v[4]; float s = 0.f;
#pragma unroll
        for (int j = 0; j < 4; ++j) { v[j] = xr[64 * j]; s += (v[j][0] * v[j][0] + v[j][1] * v[j][1]) + (v[j][2] * v[j][2] + v[j][3] * v[j][3]); }
        const float rstd = rsqrtf(wave_sum(s) * (1.0f / 1024.0f) + 1e-6f);
#pragma unroll
        for (int j = 0; j < 4; ++j) { const f32x4 gv = ((const f32x4*)gam)[lane + 64 * j]; const f32x4 y = v[j] * rstd * gv;
            if (TO_BF16) { u32x2 w; w.x = cvt_pk_bf16(y[0], y[1]); w.y = cvt_pk_bf16(y[2], y[3]); ((u32x2*)((bf16_t*)outp + (size_t)row * 1024))[lane + 64 * j] = w; }
            else ((f32x4*)((float*)outp + (size_t)row * 1024))[lane + 64 * j] = y; }
    }
}

__device__ __forceinline__ void transpose_job(const float* W, int K, int ldw, int ncols, int c0, bf16_t* WT, int r0, float scale, LAS float* scr, int gw, int ngw, int lane) {
    const int nnb = ncols / 32, nitems = (K / 64) * nnb;
    for (int it = gw; it < nitems; it += ngw) {
        const int kb = it / nnb, nb = it % nnb, k0 = kb * 64, n0 = nb * 32;
#pragma unroll 8
        for (int i = 0; i < 32; ++i) { const int kk = 2 * i + (lane >> 5); scr[kk * 33 + (lane & 31)] = W[(size_t)(k0 + kk) * ldw + c0 + n0 + (lane & 31)]; }
        asm volatile("s_waitcnt lgkmcnt(0)" ::: "memory");
        const int c = lane & 7;
#pragma unroll
        for (int j = 0; j < 4; ++j) { const int n = (lane >> 3) + 8 * j; const LAS float* sp = scr + (8 * c) * 33 + n;
            u32x4 o; o.x = cvt_pk_bf16(sp[0] * scale, sp[33] * scale); o.y = cvt_pk_bf16(sp[66] * scale, sp[99] * scale); o.z = cvt_pk_bf16(sp[132] * scale, sp[165] * scale); o.w = cvt_pk_bf16(sp[198] * scale, sp[231] * scale);
            *(u32x4*)(WT + (size_t)(r0 + n0 + n) * K + k0 + 8 * c) = o; }
        asm volatile("s_waitcnt lgkmcnt(0)" ::: "memory");
    }
}

__device__ __forceinline__ void na_phase(const bf16_t* Q, const bf16_t* Kb, const bf16_t* VT, const LAS float* rpb, bf16_t* OUT, int gw, int ngw, int lane) {
    const int fr = lane & 15, fq = lane >> 4;
    for (int unit = gw; unit < 8192; unit += ngw) {
        const int j = unit & 3, rp = (unit >> 2) & 63, h = (unit >> 8) & 7, b = unit >> 11;
        const int r0 = rp * 2, r1 = r0 + 1;
        const int kra = min(max(r0 - 4, 0), 120), krb = min(max(r1 - 4, 0), 120), dsh = krb - kra, cs = min(max(16 * j - 8, 0), 32);
        const size_t tok0 = (size_t)b * 8192 + r0 * 64 + j * 16 + fr;
        const bf16_t* qp = Q + tok0 * 512 + h * 64 + fq * 8;
        const bf16x8 qa0 = *(const bf16x8*)qp, qa1 = *(const bf16x8*)(qp + 32), qb0 = *(const bf16x8*)(qp + 64 * 512), qb1 = *(const bf16x8*)(qp + 64 * 512 + 32);
        f32x4 sa[9][2], sb[9][2];
#pragma unroll
        for (int ub = 0; ub < 3; ++ub) {
            bf16x8 kf[3][2][2];
#pragma unroll
            for (int uu = 0; uu < 3; ++uu) { const int krow = min(kra + ub * 3 + uu, 127);
#pragma unroll
                for (int t = 0; t < 2; ++t) { const int kc = cs + (fr >> 2) * 8 + t * 4 + (fr & 3);
                    const bf16_t* kp = Kb + ((size_t)b * 8192 + krow * 64 + kc) * 512 + h * 64 + fq * 8; kf[uu][t][0] = *(const bf16x8*)kp; kf[uu][t][1] = *(const bf16x8*)(kp + 32); } }
            asm volatile("" ::: "memory");
#pragma unroll
            for (int uu = 0; uu < 3; ++uu)
#pragma unroll
                for (int t = 0; t < 2; ++t) { f32x4 a = (f32x4){0.f, 0.f, 0.f, 0.f}, c = (f32x4){0.f, 0.f, 0.f, 0.f};
                    a = __builtin_amdgcn_mfma_f32_16x16x32_bf16(kf[uu][t][0], qa0, a, 0, 0, 0); c = __builtin_amdgcn_mfma_f32_16x16x32_bf16(kf[uu][t][0], qb0, c, 0, 0, 0);
                    a = __builtin_amdgcn_mfma_f32_16x16x32_bf16(kf[uu][t][1], qa1, a, 0, 0, 0); c = __builtin_amdgcn_mfma_f32_16x16x32_bf16(kf[uu][t][1], qb1, c, 0, 0, 0);
                    sa[ub * 3 + uu][t] = a; sb[ub * 3 + uu][t] = c; }
        }
        const int qcol = 16 * j + fr, wsq = min(max(qcol - 8, 0), 48);
        const LAS float* bias_h = rpb + h * 15 * 31;
        float mxa = -1e30f, mxb = -1e30f;
#pragma unroll
        for (int u = 0; u < 9; ++u) { const int krow = kra + u; const bool va = u <= 7, vb = (u >= dsh) && (u <= 7 + dsh);
            const int dra = min(max(krow - r0 + 7, 0), 14), drb = min(max(krow - r1 + 7, 0), 14);
#pragma unroll
            for (int t = 0; t < 2; ++t)
#pragma unroll
                for (int jj = 0; jj < 4; ++jj) { const int kc = cs + fq * 8 + t * 4 + jj; const bool inw = (kc >= wsq) && (kc < wsq + 16); const int dc = min(max(kc - qcol, -15), 15) + 15;
                    const float xa = (va && inw) ? sa[u][t][jj] + bias_h[dra * 31 + dc] : -1e30f; const float xb = (vb && inw) ? sb[u][t][jj] + bias_h[drb * 31 + dc] : -1e30f;
                    sa[u][t][jj] = xa; sb[u][t][jj] = xb; mxa = fmaxf(mxa, xa); mxb = fmaxf(mxb, xb); } }
        mxa = fmaxf(mxa, __shfl_xor(mxa, 16)); mxa = fmaxf(mxa, __shfl_xor(mxa, 32)); mxb = fmaxf(mxb, __shfl_xor(mxb, 16)); mxb = fmaxf(mxb, __shfl_xor(mxb, 32));
        float suma = 0.f, sumb = 0.f;
#pragma unroll
        for (int u = 0; u < 9; ++u)
#pragma unroll
            for (int t = 0; t < 2; ++t)
#pragma unroll
                for (int jj = 0; jj < 4; ++jj) { const float xa = sa[u][t][jj], xb = sb[u][t][jj]; const float pa = xa > -1e29f ? __expf(xa - mxa) : 0.f, pb = xb > -1e29f ? __expf(xb - mxb) : 0.f;
                    sa[u][t][jj] = pa; sb[u][t][jj] = pb; suma += pa; sumb += pb; }
        suma += __shfl_xor(suma, 16); suma += __shfl_xor(suma, 32); sumb += __shfl_xor(sumb, 16); sumb += __shfl_xor(sumb, 32);
        f32x4 oa[4], ob[4];
#pragma unroll
        for (int dt = 0; dt < 4; ++dt) { oa[dt] = (f32x4){0.f, 0.f, 0.f, 0.f}; ob[dt] = (f32x4){0.f, 0.f, 0.f, 0.f}; }
#pragma unroll
        for (int ub = 0; ub < 3; ++ub) {
            bf16x8 vf[3][4];
#pragma unroll
            for (int uu = 0; uu < 3; ++uu) { const int krow = min(kra + ub * 3 + uu, 127);
#pragma unroll
                for (int dt = 0; dt < 4; ++dt) vf[uu][dt] = *(const bf16x8*)(VT + ((size_t)b * 512 + h * 64 + dt * 16 + fr) * 8192 + krow * 64 + cs + fq * 8); }
            asm volatile("" ::: "memory");
#pragma unroll
            for (int uu = 0; uu < 3; ++uu) { const int u = ub * 3 + uu;
                const bf16x8 pfa = __builtin_bit_cast(bf16x8, pack8(sa[u][0], sa[u][1])), pfb = __builtin_bit_cast(bf16x8, pack8(sb[u][0], sb[u][1]));
#pragma unroll
                for (int dt = 0; dt < 4; ++dt) { oa[dt] = __builtin_amdgcn_mfma_f32_16x16x32_bf16(vf[uu][dt], pfa, oa[dt], 0, 0, 0); ob[dt] = __builtin_amdgcn_mfma_f32_16x16x32_bf16(vf[uu][dt], pfb, ob[dt], 0, 0, 0); } }
        }
        const float inva = 1.0f / suma, invb = 1.0f / sumb;
#pragma unroll
        for (int dt = 0; dt < 4; ++dt) { u32x2 w; w.x = cvt_pk_bf16(oa[dt][0] * inva, oa[dt][1] * inva); w.y = cvt_pk_bf16(oa[dt][2] * inva, oa[dt][3] * inva);
            *(u32x2*)(OUT + tok0 * 512 + h * 64 + dt * 16 + 4 * fq) = w;
            u32x2 x; x.x = cvt_pk_bf16(ob[dt][0] * invb, ob[dt][1] * invb); x.y = cvt_pk_bf16(ob[dt][2] * invb, ob[dt][3] * invb);
            *(u32x2*)(OUT + (tok0 + 64) * 512 + h * 64 + dt * 16 + 4 * fq) = x; }
    }
}

__device__ __forceinline__ void fold_phase(const bf16_t* FA, bf16_t* FAF, float* EXTRA, int gw, int ngw, int lane) {
    const int hw = ngw >> 1;
    for (int row = gw - hw; row >= 0 && row < 1024; row += hw) {
        const bf16_t* src = FA + (size_t)row * 8192; bf16_t* dst = FAF + (size_t)row * 4096;
        const float sgn = ((row & 63) <= 32) ? 1.0f : -1.0f; float dot = 0.f;
        for (int it0 = 0; it0 < 64; it0 += 16) {
            bf16_t ra[16], rb[16];
#pragma unroll
            for (int e = 0; e < 16; ++e) { const int s = (it0 + e) * 64 + lane; ra[e] = src[s]; rb[e] = src[s ? 8192 - s : 0]; }
            asm volatile("" ::: "memory");
#pragma unroll
            for (int e = 0; e < 16; ++e) { const int s = (it0 + e) * 64 + lane; const float a = bf2f(ra[e]); const float bb = s ? bf2f(rb[e]) : 0.f;
                const float v = a + sgn * bb; dst[s] = f2bf(v); dot += (s & 1) ? -v : v; }
        }
        dot = wave_sum(dot); const float mid = bf2f(src[4096]);
        if (lane == 0) { EXTRA[32 * row] = mid; EXTRA[32 * row + 1] = dot + mid; }
    }
}
__device__ __forceinline__ void tgen_phase(bf16_t* T, int gt, int ngt) {
    for (int v = gt; v < 8192 * 512; v += ngt) { const int n = v >> 9, s0 = (v & 511) * 8, k = n & 4095; const bool isSin = n >= 4096; float e[8];
#pragma unroll
        for (int i = 0; i < 8; ++i) { const float f = (float)((k * (s0 + i)) & 8191) * (1.0f / 8192.0f); e[i] = isSin ? __builtin_amdgcn_sinf(f) : __builtin_amdgcn_cosf(f); }
        u32x4 w; w.x = cvt_pk_bf16(e[0], e[1]); w.y = cvt_pk_bf16(e[2], e[3]); w.z = cvt_pk_bf16(e[4], e[5]); w.w = cvt_pk_bf16(e[6], e[7]);
        *(u32x4*)(T + (size_t)v * 8) = w; }
}
__device__ __forceinline__ void fcombine_phase(const float* RF, const float* EXTRA, bf16_t* OUTFN, LAS float* tile, int blk, int nblk, int tid) {
    const float scale = 0.001381067932f;
    const bool deal = (nblk == 256); const int nmine = deal ? (blk < 128 ? 3 : 5) : (1024 - blk + nblk - 1) / nblk, tbase = deal ? (blk < 128 ? blk * 3 : 384 + (blk - 128) * 5) : blk;
    for (int q_ = 0; q_ < nmine; ++q_) { const int ti = deal ? tbase + q_ : tbase + q_ * nblk;
        const int kt = ti & 63, g = (ti >> 6) & 3, b = ti >> 8, rowb = b * 256 + g * 64;
#pragma unroll
        for (int i = 0; i < 8; ++i) { const int idx = tid + 512 * i, kk = idx & 63, jr = idx >> 6, row = rowb + jr; const size_t o = (size_t)row * 4096 + kt * 64 + kk;
            float v = RF[o] + RF[o + (size_t)1024 * 4096];
            if (jr <= 32) { const float e = EXTRA[32 * row]; v += (kk & 1) ? -e : e; }
            tile[jr * 65 + kk] = v; }
        __syncthreads();
#pragma unroll
        for (int i = 0; i < 16; ++i) { const int o = tid + 512 * i, m = o & 63, kk = (o >> 6) & 63, side = o >> 12, kp = kt * 64 + kk;
            const int mp = m <= 32 ? m : 64 - m; float sg = m <= 32 ? -1.f : 1.f; if (side) sg = -sg;
            float A = tile[mp * 65 + kk]; float B = (mp == 0 || mp == 32) ? 0.f : tile[(32 + mp) * 65 + kk];
            int k;
            if (side == 0) k = kp; else if (kp != 0) k = 8192 - kp; else { k = 4096; A = EXTRA[32 * (rowb + mp) + 1]; B = 0.f; }
            if (!FC_NOSTORE || A == 123456.789f) OUTFN[((size_t)b * 8192 + k) * 256 + g * 64 + m] = f2bf((A + sg * B) * scale); }
        __syncthreads();
    }
}

__device__ __forceinline__ void scan_phase(const float* XLOC, bf16_t* SA, const f32x2* LPl, LAS float* sh, int blk, int tid) {
    if (blk >= 128) return;
    const int d = blk & 1, g = (blk >> 1) & 15, b = blk >> 5, p = tid & 63, seg = tid >> 6;
    const f32x2 lt = LPl[(((size_t)d * 16 + g) * 64 + p) * 17 + 16];
    const size_t rowbase = (size_t)g * 2048 + b * 512;
    const float lr = lt[0], li = lt[1];
    float ar = 0.f, ai = 0.f;
    for (int i0 = 0; i0 < 64; i0 += 16) { float xr[16], xi[16];
#pragma unroll
        for (int e = 0; e < 16; ++e) { const int i = seg * 64 + i0 + e, ch = d ? 511 - i : i; const float* px = XLOC + (rowbase + ch) * 256 + d * 128 + p; xr[e] = px[0]; xi[e] = px[64]; }
#pragma unroll
        for (int e = 0; e < 16; ++e) { const float nr = lr * ar - li * ai + xr[e], ni = lr * ai + li * ar + xi[e]; ar = nr; ai = ni; } }
    sh[(seg * 64 + p) * 2] = ar; sh[(seg * 64 + p) * 2 + 1] = ai;
    __syncthreads();
    float l64r = lr, l64i = li;
#pragma unroll
    for (int q = 0; q < 6; ++q) { const float nr = l64r * l64r - l64i * l64i, ni = 2.f * l64r * l64i; l64r = nr; l64i = ni; }
    float Xr = 0.f, Xi = 0.f;
    for (int k = 0; k < seg; ++k) { const float sr = sh[(k * 64 + p) * 2], si = sh[(k * 64 + p) * 2 + 1]; const float nr = l64r * Xr - l64i * Xi + sr, ni = l64r * Xi + l64i * Xr + si; Xr = nr; Xi = ni; }
    for (int i0 = 0; i0 < 64; i0 += 16) { float xr[16], xi[16];
#pragma unroll
        for (int e = 0; e < 16; ++e) { const int i = seg * 64 + i0 + e, ch = d ? 511 - i : i; const float* px = XLOC + (rowbase + ch) * 256 + d * 128 + p; xr[e] = px[0]; xi[e] = px[64]; }
#pragma unroll
        for (int e = 0; e < 16; ++e) { const int i = seg * 64 + i0 + e, ch = d ? 511 - i : i; bf16_t* ps = SA + (rowbase + ch) * 512 + 256 + d * 128 + p;
            ps[0] = f2bf(Xr); ps[64] = f2bf(Xi);
            const float nr = lr * Xr - li * Xi + xr[e], ni = lr * Xi + li * Xr + xi[e]; Xr = nr; Xi = ni; } }
    __syncthreads();
}

__device__ __forceinline__ void ssm_prep_a(const float* log_dt, const float* a_re, const float* a_im, const float* b_re, const float* b_im, f32x2* LP, f32x2* BB, int gt, int ngt) {
    for (int i = gt; i < NLAYER * 2 * 16 * 64; i += ngt) {
        const int ldg = i >> 6;
        const double dt = (double)__expf(log_dt[ldg]);
        const double are = (double)a_re[i], aim = (double)a_im[i];
        const float mag = __expf((float)(are * dt));
        const double ang = aim * dt; const double rr = ang - 6.283185307179586 * rint(ang * 0.15915494309189535);
        const double q = rr * 0.125, q2 = q * q;
        double s = q * (1.0 - q2 / 6.0 * (1.0 - q2 / 20.0 * (1.0 - q2 / 42.0 * (1.0 - q2 / 72.0 * (1.0 - q2 / 110.0 * (1.0 - q2 / 156.0))))));
        double c = 1.0 - q2 / 2.0 * (1.0 - q2 / 12.0 * (1.0 - q2 / 30.0 * (1.0 - q2 / 56.0 * (1.0 - q2 / 90.0 * (1.0 - q2 / 132.0)))));
#pragma unroll
        for (int k = 0; k < 3; ++k) { const double s2 = 2.0 * s * c, c2 = 1.0 - 2.0 * s * s; s = s2; c = c2; }
        const double lbr = (double)mag * c, lbi = (double)mag * s;
        double pr = 1.0, pi = 0.0;
        for (int tau = 0; tau <= 16; ++tau) { LP[(size_t)i * 17 + tau] = (f32x2){(float)pr, (float)pi}; const double nr = pr * lbr - pi * lbi, ni = pr * lbi + pi * lbr; pr = nr; pi = ni; }
        const double nr_ = lbr - 1.0, ni_ = lbi, den = are * are + aim * aim; const double fr_ = (nr_ * are + ni_ * aim) / den, fi_ = (ni_ * are - nr_ * aim) / den;
        for (int c_ = 0; c_ < 16; ++c_) { const double br = (double)b_re[(size_t)i * 16 + c_], bi = (double)b_im[(size_t)i * 16 + c_];
            BB[(size_t)i * 16 + c_] = (f32x2){(float)(fr_ * br - fi_ * bi), (float)(fr_ * bi + fi_ * br)}; }
    }
}
__device__ __forceinline__ void ssm_prep_b(const float* c_re, const float* c_im, const f32x2* LP, const f32x2* BB, float* KT, int gt, int ngt) {
    for (int i = gt; i < NLAYER * 2 * 16 * 16 * 256; i += ngt) {
        const int cp = i & 15, c = (i >> 4) & 15, tau = (i >> 8) & 15, ldg = i >> 12;
        const float* cre = c_re + ((size_t)ldg * 16 + c) * 64; const float* cim = c_im + ((size_t)ldg * 16 + c) * 64;
        float accv = 0.f;
        for (int p = 0; p < 64; ++p) { const f32x2 l = LP[((size_t)ldg * 64 + p) * 17 + tau], bb = BB[((size_t)ldg * 64 + p) * 16 + cp];
            const float tr = l[0] * bb[0] - l[1] * bb[1], ti = l[0] * bb[1] + l[1] * bb[0]; accv += cre[p] * tr - cim[p] * ti; }
        KT[i] = accv;
    }
}
__device__ __forceinline__ void ssm_fill(const float* c_re, const float* c_im, const float* d_skip, int l, const f32x2* LP, const f32x2* BB, const float* KT, bf16_t* BT1, bf16_t* BT2, int gt, int ngt) {
    const f32x2* LPl = LP + (size_t)l * 2 * 16 * 64 * 17; const f32x2* BBl = BB + (size_t)l * 2 * 16 * 64 * 16; const float* KTl = KT + (size_t)l * 2 * 16 * 16 * 256;
    for (int i = gt; i < 16 * 256 * 256; i += ngt) {
        const int col = i & 255, jrow = (i >> 8) & 255, g = i >> 16, tp = col >> 4, cp = col & 15, d = jrow >> 7, p = jrow & 63; const bool im = (jrow & 64) != 0;
        const f32x2 lam = LPl[(((size_t)d * 16 + g) * 64 + p) * 17 + (d ? tp : 15 - tp)], bb = BBl[(((size_t)d * 16 + g) * 64 + p) * 16 + cp];
        BT1[i] = f2bf(im ? lam[0] * bb[1] + lam[1] * bb[0] : lam[0] * bb[0] - lam[1] * bb[1]);
    }
    const float* Dl = d_skip + (size_t)l * 256; const float* Cre = c_re + (size_t)l * 2 * 16 * 16 * 64; const float* Cim = c_im + (size_t)l * 2 * 16 * 16 * 64;
    for (int i = gt; i < 16 * 256 * 512; i += ngt) {
        const int col = i & 511, row = (i >> 9) & 255, g = i >> 17, t = row >> 4, c = row & 15; float v;
        if (col < 256) { const int tp = col >> 4, cp = col & 15, tau = t - tp;
            if (tau > 0) v = KTl[(((size_t)0 * 16 + g) * 16 + tau) * 256 + c * 16 + cp];
            else if (tau < 0) v = KTl[(((size_t)1 * 16 + g) * 16 - tau) * 256 + c * 16 + cp];
            else v = KTl[(((size_t)0 * 16 + g) * 16) * 256 + c * 16 + cp] + KTl[(((size_t)1 * 16 + g) * 16) * 256 + c * 16 + cp] + (c == cp ? Dl[g * 16 + c] : 0.f);
        } else { const int jc = col - 256, d = jc >> 7, p = jc & 63; const bool im = (jc & 64) != 0;
            const f32x2 lam = LPl[(((size_t)d * 16 + g) * 64 + p) * 17 + (d ? 16 - t : t + 1)];
            const float cr = Cre[(((size_t)d * 16 + g) * 16 + c) * 64 + p], ci = Cim[(((size_t)d * 16 + g) * 16 + c) * 64 + p];
            v = im ? -(cr * lam[1] + ci * lam[0]) : (cr * lam[0] - ci * lam[1]); }
        BT2[i] = f2bf(v);
    }
}
__device__ __forceinline__ void wfold_job(const float* Win, bf16_t* WT, int gt, int ngt) {
    for (int i = gt; i < 256 * 1024; i += ngt) { const int k = i & 1023, n = i >> 10, g = n >> 6, j = n & 63; const int mm = j <= 32 ? j : j - 32; const bool isSin = j > 32;
        const float* w = Win + (size_t)k * 5120 + g * 64; float a = 0.f;
        for (int c = 0; c < 64; ++c) { const float f = (float)((mm * c) & 63) * (1.0f / 64.0f); a += w[c] * (isSin ? __builtin_amdgcn_sinf(f) : __builtin_amdgcn_cosf(f)); }
        WT[(size_t)n * 1024 + k] = f2bf(a); }
}

#ifndef SUB3
#define SUB3 3
#endif
#ifndef SUB4
#define SUB4 3
#endif
#ifndef SUB6
#define SUB6 7
#endif
#ifndef FFN_ONLY
#define FFN_ONLY 0
#endif
#ifndef ZBR
#define ZBR 0
#endif
#ifndef SUBMASK
#define SUBMASK 0xff
#endif
#ifndef PHMASK
#define PHMASK 0xffff
#endif
constexpr int LDS_BYTES = STAGE_BYTES + 20480;
constexpr int PH_PER_LAYER = 11, PH_INIT = 2, PH_TOTAL = PH_INIT + NLAYER * PH_PER_LAYER + 1;

__global__ void __launch_bounds__(512, 2) fwd_megakernel(Params P) {
    extern __shared__ __attribute__((aligned(16))) unsigned char shm[];
    LAS unsigned char* lds = (LAS unsigned char*)shm;
    LAS float* ldsf = (LAS float*)(shm + STAGE_BYTES);
    cg::grid_group grid = cg::this_grid();
    const int blk = blockIdx.x, nblk = gridDim.x;
    const int ph_lo = P.ph_lo, ph_hi = P.ph_hi;
    grid.sync();
#define KA __attribute__((address_space(4)))
#define FRESH_IDS int tid = threadIdx.x; asm volatile("" : "+v"(tid)); const int lane = tid & 63, wave = tid >> 6, gw = blk * 8 + wave, ngw = nblk * 8, gt = blk * 512 + tid, ngt = nblk * 512; (void)lane; (void)gw; (void)ngw; (void)gt; (void)ngt;
#define WSP(T, off) ((T*)(ws + (off)))
    for (int ph = ph_lo; ph < ph_hi; ++ph) {
        const KA Params* kp = (const KA Params*)__builtin_amdgcn_kernarg_segment_ptr();
        asm volatile("" : "+s"(kp));
        unsigned char* ws = kp->ws;
        if (LDS_CLEAR) { int t_ = threadIdx.x; asm volatile("" : "+v"(t_)); for (int z = t_; z < STAGE_BYTES / 16; z += 512) ((LAS u32x4*)lds)[z] = (u32x4){0u, 0u, 0u, 0u}; __syncthreads(); }
        if (ph == 0) { if constexpr ((PHMASK >> 11) & 1) { FRESH_IDS; ssm_prep_a(kp->in[6], kp->in[4], kp->in[5], kp->in[7], kp->in[8], WSP(f32x2, WS_LP), WSP(f32x2, WS_BB), gt, ngt); } }
        else if (ph == 1) { if constexpr ((PHMASK >> 11) & 1) { FRESH_IDS; ssm_prep_b(kp->in[9], kp->in[10], WSP(f32x2, WS_LP), WSP(f32x2, WS_BB), WSP(float, WS_KT), gt, ngt); } }
        else if (ph == PH_TOTAL - 1) { FRESH_IDS; norm_phase<false>(kp->out, kp->in[20], kp->out, gw, ngw, lane); }
        else {
            const int l = (ph - PH_INIT) / PH_PER_LAYER, lp = (ph - PH_INIT) % PH_PER_LAYER;
            switch (lp) {
            case 0: if constexpr ((PHMASK >> 0) & 1) {
                const float* Win = kp->in[2] + (size_t)l * 1024 * 5120;
                { FRESH_IDS; LAS float* wscr = (LAS float*)(lds + wave * 16384);
                transpose_job(Win, 1024, 5120, 512, 256, WSP(bf16_t, W_IN), 256, 0.125f, wscr, gw, ngw, lane);
                transpose_job(Win, 1024, 5120, 4352, 768, WSP(bf16_t, W_IN), 768, 1.0f, wscr, gw, ngw, lane);
                transpose_job(kp->in[13] + (size_t)l * 256 * 1024, 256, 1024, 1024, 0, WSP(bf16_t, W_BRFN), 0, 1.0f, wscr, gw, ngw, lane);
                transpose_job(kp->in[14] + (size_t)l * 512 * 1024, 512, 1024, 1024, 0, WSP(bf16_t, W_BRNA), 0, 1.0f, wscr, gw, ngw, lane);
                transpose_job(kp->in[15] + (size_t)l * 256 * 1024, 256, 1024, 1024, 0, WSP(bf16_t, W_BRSSM), 0, 1.0f, wscr, gw, ngw, lane);
                transpose_job(kp->in[16] + (size_t)l * 1024 * 1024, 1024, 1024, 1024, 0, WSP(bf16_t, W_OUT), 0, 1.0f, wscr, gw, ngw, lane);
                transpose_job(kp->in[18] + (size_t)l * 1024 * 4096, 1024, 4096, 4096, 0, WSP(bf16_t, W_UP), 0, 1.0f, wscr, gw, ngw, lane);
                transpose_job(kp->in[19] + (size_t)l * 4096 * 1024, 4096, 1024, 1024, 0, WSP(bf16_t, W_DOWN), 0, 1.0f, wscr, gw, ngw, lane);
                transpose_job(kp->in[12] + (size_t)l * 256 * 256, 256, 256, 256, 0, WSP(bf16_t, W_GLU), 0, 1.0f, wscr, gw, ngw, lane);
                wfold_job(Win, WSP(bf16_t, W_IN), gt, ngt);
                ssm_fill(kp->in[9], kp->in[10], kp->in[11], l, WSP(f32x2, WS_LP), WSP(f32x2, WS_BB), WSP(float, WS_KT), WSP(bf16_t, W_BT1), WSP(bf16_t, W_BT2), gt, ngt);
                norm_phase<true>(l == 0 ? kp->in[0] : kp->out, kp->in[1] + (size_t)l * 1024, WSP(bf16_t, WS_H), gw, ngw, lane); }
            } break;
            case 1: if constexpr ((PHMASK >> 1) & 1) {
                StaticOrder S; S.init(NTOK, 2048, nblk, blk); EpiZ E{WSP(bf16_t, R1_Q), WSP(bf16_t, R1_K), WSP(bf16_t, R1_VT), WSP(bf16_t, R1_FA), WSP(bf16_t, R1_SA)};
                gemm_phase(lds, Gemm{WSP(bf16_t, WS_H), WSP(bf16_t, W_IN), 1024, 1024, 1024}, S, E);
            } break;
            case 2: if constexpr ((PHMASK >> 2) & 1) {
                if constexpr (SUBMASK & 1) { DiagOrder S{nblk, blk}; EpiF32 E{WSP(float, R1_XLOC), 256}; gemm_phase(lds, Gemm{WSP(bf16_t, R1_SA), WSP(bf16_t, W_BT1), 256, 512, 256}, S, E); }
                if constexpr (SUBMASK & 2) { FRESH_IDS; const float* rpbl = kp->in[3] + (size_t)l * 8 * 15 * 31;
                    for (int z = tid; z < 8 * 15 * 31; z += 512) ldsf[z] = rpbl[z];
                    __syncthreads();
                    na_phase(WSP(bf16_t, R1_Q), WSP(bf16_t, R1_K), WSP(bf16_t, R1_VT), ldsf, WSP(bf16_t, WS_OUTNA), gw, ngw, lane);
                    __syncthreads(); }
                if constexpr (SUBMASK & 4) { FRESH_IDS; fold_phase(WSP(bf16_t, R1_FA), WSP(bf16_t, R1_FAF), WSP(float, R1_EXTRA), gw, ngw, lane); }
                if constexpr (SUBMASK & 8) if (l == 0) { FRESH_IDS; tgen_phase(WSP(bf16_t, WS_T), gt, ngt); }
            } break;
            case 3: if constexpr ((PHMASK >> 3) & 1) {
                if constexpr (SUB3 & 1) { FourierOrder S{nblk, blk}; EpiFour E{WSP(float, R1_RF)}; gemm_phase(lds, Gemm{WSP(bf16_t, R1_FAF), WSP(bf16_t, WS_T), 2048, 4096, 4096}, S, E); }
                if constexpr (SUB3 & 2) { FRESH_IDS; scan_phase(WSP(float, R1_XLOC), WSP(bf16_t, R1_SA), WSP(f32x2, WS_LP) + (size_t)l * 2 * 16 * 64 * 17, ldsf, blk, tid); }
            } break;
            case 4: if constexpr ((PHMASK >> 4) & 1) {
                if constexpr (SUB4 & 1) { DiagOrder S{nblk, blk}; EpiSsmY E{WSP(bf16_t, R1_YG)}; gemm_phase(lds, Gemm{WSP(bf16_t, R1_SA), WSP(bf16_t, W_BT2), 512, 512, 512}, S, E); }
                if constexpr (SUB4 & 2) { FRESH_IDS; fcombine_phase(WSP(float, R1_RF), WSP(float, R1_EXTRA), WSP(bf16_t, WS_OUTFN), ldsf, blk, nblk, tid);
                    for (int z = tid; z < 64 * 65; z += 512) ldsf[z] = 0.f; __syncthreads(); }
            } break;
            case 5: if constexpr ((PHMASK >> 5) & 1) {
                if constexpr (SUBMASK & 1) { StaticOrder S; S.init(NTOK, 256, nblk, blk); EpiGlu E{WSP(bf16_t, R1_YG), WSP(bf16_t, WS_OUTSSM)}; gemm_phase(lds, Gemm{WSP(bf16_t, R1_YG), WSP(bf16_t, W_GLU), 256, 256, 256}, S, E); }
                if constexpr (SUBMASK & 2) { StaticOrder S; S.init(NTOK, 3072, nblk, blk); EpiGate E{WSP(bf16_t, R1_G)}; gemm_phase(lds, Gemm{WSP(bf16_t, WS_H), WSP(bf16_t, W_IN) + (size_t)2048 * 1024, 1024, 1024, 1024}, S, E); }
            } break;
            case 6: if constexpr ((PHMASK >> 6) & 1) {
                StaticOrder S; S.init(NTOK, 1024, nblk, blk);
                if constexpr (SUB6 & 1) { EpiMerge<true> E{WSP(bf16_t, R1_G), WSP(bf16_t, WS_H), (ZBR & 1) ? 0.f : 1.f}; gemm_phase(lds, Gemm{WSP(bf16_t, WS_OUTFN), WSP(bf16_t, W_BRFN), 256, 256, 256}, S, E); }
                if constexpr (SUB6 & 2) { EpiMerge<false> E{WSP(bf16_t, R1_G) + (size_t)NTOK * 1024, WSP(bf16_t, WS_H), (ZBR & 2) ? 0.f : 1.f}; gemm_phase(lds, Gemm{WSP(bf16_t, WS_OUTNA), WSP(bf16_t, W_BRNA), 512, 512, 512}, S, E); }
                if constexpr (SUB6 & 4) { EpiMerge<false> E{WSP(bf16_t, R1_G) + (size_t)2 * NTOK * 1024, WSP(bf16_t, WS_H), (ZBR & 4) ? 0.f : 1.f}; gemm_phase(lds, Gemm{WSP(bf16_t, WS_OUTSSM), WSP(bf16_t, W_BRSSM), 256, 256, 256}, S, E); }
            } break;
            case 7: if constexpr ((PHMASK >> 7) & 1) {
                StaticOrder S; S.init(NTOK, 1024, nblk, blk); EpiRes E{l == 0 ? kp->in[0] : kp->out, kp->out};
                gemm_phase(lds, Gemm{WSP(bf16_t, WS_H), WSP(bf16_t, W_OUT), 1024, 1024, 1024}, S, E);
            } break;
            case 8: if constexpr ((PHMASK >> 8) & 1) { FRESH_IDS; norm_phase<true>((FFN_ONLY && l == 0) ? kp->in[0] : kp->out, kp->in[17] + (size_t)l * 1024, WSP(bf16_t, WS_H), gw, ngw, lane); } break;
            case 9: if constexpr ((PHMASK >> 9) & 1) {
                StaticOrder S; S.init(NTOK, 4096, nblk, blk); EpiUp E{WSP(bf16_t, R1_HID)};
                gemm_phase(lds, Gemm{WSP(bf16_t, WS_H), WSP(bf16_t, W_UP), 1024, 1024, 1024}, S, E);
            } break;
            case 10: if constexpr ((PHMASK >> 10) & 1) {
                StaticOrder S; S.init(NTOK, 1024, nblk, blk); EpiRes E{(FFN_ONLY && l == 0) ? kp->in[0] : kp->out, kp->out};
                gemm_phase(lds, Gemm{WSP(bf16_t, R1_HID), WSP(bf16_t, W_DOWN), 4096, 4096, 4096}, S, E);
            } break;
            }
        }
        if (ph + 1 < ph_hi) {
            asm volatile("s_waitcnt vmcnt(0) lgkmcnt(0)" ::: "memory");
            __syncthreads();
            if (threadIdx.x == 0) {
                unsigned* bar = (unsigned*)(ws + WS_BAR);
                __builtin_amdgcn_fence(__ATOMIC_RELEASE, "agent"); asm volatile("s_waitcnt vmcnt(0)" ::: "memory");
                const unsigned k = (unsigned)(ph - ph_lo + 1), gsz = (unsigned)nblk >> 4;
                const unsigned old = __hip_atomic_fetch_add(bar + 16 * (1 + (blk & 15)), 1u, __ATOMIC_RELAXED, __HIP_MEMORY_SCOPE_AGENT);
                if (old + 1u == k * gsz) __hip_atomic_fetch_add(bar, 1u, __ATOMIC_RELAXED, __HIP_MEMORY_SCOPE_AGENT);
                while (__hip_atomic_load(bar, __ATOMIC_RELAXED, __HIP_MEMORY_SCOPE_AGENT) < k * 16u) __builtin_amdgcn_s_sleep(1);
                __builtin_amdgcn_fence(__ATOMIC_ACQUIRE, "agent");
                asm volatile("s_waitcnt vmcnt(0)" ::: "memory");
            }
            __syncthreads();
        }
    }
}

extern "C" void kernel_launch(void* const* d_in, const int* in_sizes, int n_in, void* d_out, int out_size, void* d_ws, size_t ws_size, hipStream_t stream) {
    static int grid_blocks = 0;
    if (!grid_blocks) {
        if (n_in != 21 || out_size != NTOK * DM || ws_size < WS_END) { fprintf(stderr, "kernel_launch: unexpected problem (n_in %d out %d ws %zu need %zu)\n", n_in, out_size, ws_size, (size_t)WS_END); grid_blocks = -1; return; }
        int dev = 0, cus = 0, per_cu = 0;
        hipGetDevice(&dev);
        hipDeviceGetAttribute(&cus, hipDeviceAttributeMultiprocessorCount, dev);
        if (hipFuncSetAttribute((const void*)fwd_megakernel, hipFuncAttributeMaxDynamicSharedMemorySize, LDS_BYTES) != hipSuccess) { fprintf(stderr, "kernel_launch: hipFuncSetAttribute failed\n"); grid_blocks = -1; return; }
        if (hipOccupancyMaxActiveBlocksPerMultiprocessor(&per_cu, (const void*)fwd_megakernel, 512, LDS_BYTES) != hipSuccess || per_cu < 1) { fprintf(stderr, "kernel_launch: occupancy query says %d\n", per_cu); per_cu = 1; }
        (void)hipGetLastError();
        grid_blocks = cus - (cus % 16);
    }
    if (grid_blocks < 0) return;
    Params p{};
    for (int i = 0; i < 21; ++i) p.in[i] = (const float*)d_in[i];
    p.out = (float*)d_out; p.ws = (unsigned char*)d_ws;
    if (hipMemsetAsync((unsigned char*)d_ws + WS_BAR, 0, 2048, stream) != hipSuccess) { fprintf(stderr, "kernel_launch: memset failed\n"); return; }
#if PER_PHASE_LAUNCH
    for (int ph = 0; ph < PH_TOTAL; ++ph) { p.ph_lo = ph; p.ph_hi = ph + 1; void* args[] = {&p};
        hipError_t e = hipLaunchCooperativeKernel((const void*)fwd_megakernel, dim3(grid_blocks), dim3(512), args, LDS_BYTES, stream);
        if (e != hipSuccess) { fprintf(stderr, "cooperative launch failed: %s (phase %d)\n", hipGetErrorString(e), ph); return; } }
#else
    p.ph_lo = 0; p.ph_hi = PH_TOTAL; void* args[] = {&p};
    hipError_t e = hipLaunchCooperativeKernel((const void*)fwd_megakernel, dim3(grid_blocks), dim3(512), args, LDS_BYTES, stream);
    if (e != hipSuccess) fprintf(stderr, "cooperative launch failed: %s (grid %d)\n", hipGetErrorString(e), grid_blocks);
#endif
}
```

```cpp
#include <hip/hip_runtime.h>
#include <hip/hip_cooperative_groups.h>
#include <cstdio>
namespace cg = cooperative_groups;

#ifndef FC_NOSTORE
#define FC_NOSTORE 0
#endif
#ifndef LDS_CLEAR
#define LDS_CLEAR 0
#endif
#ifndef SAFE_VM
#define SAFE_VM 0
#endif
#ifndef GCONST
#define GCONST 0
#endif
#ifndef PER_PHASE_LAUNCH
#define PER_PHASE_LAUNCH 0
#endif

#define LAS __attribute__((address_space(3)))
typedef unsigned short bf16_t;
typedef short bf16x8 __attribute__((ext_vector_type(8)));
typedef float f32x4 __attribute__((ext_vector_type(4)));
typedef float f32x2 __attribute__((ext_vector_type(2)));
typedef unsigned u32x4 __attribute__((ext_vector_type(4)));
typedef unsigned u32x2 __attribute__((ext_vector_type(2)));

constexpr int NTOK = 32768, DM = 1024, DFF = 4096, SEQ = 8192, NLAYER = 4;
constexpr size_t MiB = 1ull << 20;
constexpr size_t WS_H = 0;
constexpr size_t WS_T = 64 * MiB;
constexpr size_t WS_R1 = 128 * MiB;
constexpr size_t R1_Q = WS_R1, R1_K = WS_R1 + 32 * MiB, R1_VT = WS_R1 + 64 * MiB, R1_FA = WS_R1 + 96 * MiB, R1_FAF = WS_R1 + 112 * MiB,
                 R1_RF = WS_R1 + 120 * MiB, R1_SA = WS_R1 + 152 * MiB, R1_XLOC = WS_R1 + 184 * MiB, R1_YG = WS_R1 + 216 * MiB, R1_EXTRA = WS_R1 + 232 * MiB;
constexpr size_t R1_G = WS_R1, R1_HID = WS_R1;
constexpr size_t WS_OUTFN = 384 * MiB, WS_OUTNA = 400 * MiB, WS_OUTSSM = 432 * MiB;
constexpr size_t WS_W = 448 * MiB;
constexpr size_t W_IN = WS_W, W_BRFN = WS_W + 10 * MiB, W_BRNA = W_BRFN + MiB / 2, W_BRSSM = W_BRNA + MiB, W_OUT = WS_W + 12 * MiB, W_UP = WS_W + 14 * MiB,
                 W_DOWN = WS_W + 22 * MiB, W_GLU = WS_W + 30 * MiB, W_BT1 = W_GLU + MiB / 2, W_BT2 = W_BT1 + 2 * MiB;
constexpr size_t WS_LP = 485 * MiB;
constexpr size_t WS_BB = WS_LP + 5 * MiB / 4;
constexpr size_t WS_KT = WS_BB + MiB;
constexpr size_t WS_BAR = WS_KT + 2 * MiB;
constexpr size_t WS_END = WS_BAR + 4096;

struct Params {
    const float* in[21];
    float* out; unsigned char* ws;
    int ph_lo, ph_hi;
};

typedef __bf16 bf16x2_t __attribute__((ext_vector_type(2)));
__device__ __forceinline__ unsigned cvt_pk_bf16(float lo, float hi) { const f32x2 v = {lo, hi}; const bf16x2_t r = __builtin_convertvector(v, bf16x2_t); return __builtin_bit_cast(unsigned, r); }
__device__ __forceinline__ bf16_t f2bf(float v) { return (bf16_t)(cvt_pk_bf16(v, 0.f) & 0xffffu); }
__device__ __forceinline__ float bf2f(bf16_t b) { return __uint_as_float(((unsigned)b) << 16); }
__device__ __forceinline__ float bflo(unsigned w) { return __uint_as_float(w << 16); }
__device__ __forceinline__ float bfhi(unsigned w) { return __uint_as_float(w & 0xffff0000u); }
__device__ __forceinline__ float sigmoidf_(float x) { return __builtin_amdgcn_rcpf(1.0f + __expf(-x)); }
__device__ __forceinline__ float gelu_tanh(float x) { const float u = 0.7978845608028654f * (x + 0.044715f * x * x * x); return x * sigmoidf_(2.0f * u); }
__device__ __forceinline__ float wave_sum(float v) {
#pragma unroll
    for (int o = 1; o < 64; o <<= 1) v += __shfl_xor(v, o);
    return v;
}
__device__ __forceinline__ u32x4 pack8(const f32x4 a, const f32x4 b) { u32x4 w; w.x = cvt_pk_bf16(a[0], a[1]); w.y = cvt_pk_bf16(a[2], a[3]); w.z = cvt_pk_bf16(b[0], b[1]); w.w = cvt_pk_bf16(b[2], b[3]); return w; }

constexpr int BM = 256, BK = 64, HALF = 128, HTB = HALF * BK * 2, STAGE_BYTES = 8 * HTB, NXCD = 8, WGM = 8;
__device__ __forceinline__ int lds_byte(int r, int c) { const int st = (r >> 4) * 2 + (c >> 5), rr = r & 15, cc = c & 31, ob = rr * 64 + cc * 2; return st * 1024 + (ob ^ (((ob >> 9) & 1) << 5)); }
__device__ __forceinline__ void stage_rc(int b, int& R, int& C) { const int st = b / 1024, sb = b % 1024, swz = sb ^ (((sb >> 9) & 1) << 5); R = (st >> 1) * 16 + swz / 64; C = (st & 1) * 32 + (swz % 64) / 2; }
__device__ __forceinline__ int perm32(int rho) { const int n = rho >> 4, i = rho & 15; return 8 * (i >> 2) + 4 * n + (i & 3); }

struct Unit { int pm, pn, ko, kh; };
struct Gemm { const bf16_t* A; const bf16_t* Bt; int K, lda, ldb; };

struct StaticOrder {
    int nM, nN, nwg, G, c;
    __device__ void init(int M, int N, int G_, int c_) { nM = M / BM; nN = N / BM; nwg = nM * nN; G = G_; c = c_; }
    __device__ bool next(int i, Unit& u) const {
        const long L = (long)i * G + c; if (L >= nwg) return false;
        int wgid = (int)L; { const int q = nwg / NXCD, r = nwg % NXCD, xcd = wgid % NXCD, off = wgid / NXCD; wgid = (xcd < r ? xcd * (q + 1) : r * (q + 1) + (xcd - r) * q) + off; }
        const int nig = WGM * nN, gid = wgid / nig, fm = gid * WGM, gsz = (nM - fm) < WGM ? (nM - fm) : WGM;
        u.pm = fm + ((wgid % nig) % gsz); u.pn = (wgid % nig) / gsz; u.ko = 0; u.kh = 0; return true;
    }
};
struct DiagOrder {
    int G, c;
    __device__ bool next(int i, Unit& u) const { const long L = (long)i * G + c; if (L >= 128) return false; u.pm = (int)L; u.pn = (int)L >> 3; u.ko = 0; u.kh = 0; return true; }
};
struct FourierOrder {
    int G, c;
    __device__ bool next(int i, Unit& u) const { const long L = (long)i * G + c; if (L >= 256) return false; const int l = (int)L; u.kh = l & 1; u.pm = (l >> 1) & 3; u.pn = l >> 3; u.ko = u.kh * 2048; return true; }
};

template <class Epi, class Sched>
__device__ __forceinline__ void gemm_phase(LAS unsigned char* lds, const Gemm g, const Sched& S, const Epi& E) {
    int tid = threadIdx.x; asm volatile("" : "+v"(tid));
    const int wid = __builtin_amdgcn_readfirstlane(tid >> 6), lane = tid & 63, wr = wid >> 2, wc = wid & 3, fr = lane & 15, fq = lane >> 4;
    int K = g.K; asm volatile("" : "+s"(K)); const int nt = K / BK;
    unsigned voffA[2], voffB[2];
#pragma unroll
    for (int i = 0; i < 2; ++i) { int R, C; stage_rc(tid * 16 + i * 8192, R, C); const int Rb = Epi::PERM ? ((R & ~31) + perm32(R & 31)) : R;
        voffA[i] = (unsigned)(R * g.lda + C) * 2u; voffB[i] = (unsigned)(Rb * g.ldb + C) * 2u; }
    const size_t kstep = (size_t)(BK * 2);
    const size_t hstepA = (size_t)HALF * g.lda * 2, hstepB = (size_t)HALF * g.ldb * 2;
    const size_t tstepA = 2 * hstepA, tstepB = 2 * hstepB;
    const unsigned ldsw = (unsigned)wid * 1024u;
    const int aoff = lds_byte(wr * 64 + fr, fq * 8), boff = lds_byte(wc * 32 + fr, fq * 8);
#define PG8_SA(b, h) (((b) * 2 + (h)) * HTB)
#define PG8_SB(b, h) ((4 + (b) * 2 + (h)) * HTB)
#define PG8_STAGE(bufoff, gbase, voff) do { _Pragma("unroll") for (int _i = 0; _i < 2; ++_i) \
        __builtin_amdgcn_global_load_lds((const unsigned*)((const char*)(gbase) + (voff)[_i]), (LAS unsigned*)(lds + (bufoff) + ldsw + _i * 8192), 16, 0, 0); } while (0)
#define PG8_LDA(dst, b, h) do { _Pragma("unroll") for (int m = 0; m < 4; ++m) _Pragma("unroll") for (int k = 0; k < 2; ++k) dst[m][k] = *(const LAS bf16x8*)(lds + PG8_SA(b, h) + aoff + m * 2048 + k * 1024); } while (0)
#define PG8_LDB(dst, b, h) do { _Pragma("unroll") for (int n = 0; n < 2; ++n) _Pragma("unroll") for (int k = 0; k < 2; ++k) dst[n][k] = *(const LAS bf16x8*)(lds + PG8_SB(b, h) + boff + n * 2048 + k * 1024); } while (0)
#define PG8_MMA(ai, bj, At, Bt) do { __builtin_amdgcn_s_setprio(1); _Pragma("unroll") for (int m = 0; m < 4; ++m) _Pragma("unroll") for (int n = 0; n < 2; ++n) _Pragma("unroll") for (int k = 0; k < 2; ++k) \
        acc[ai][bj][m][n] = __builtin_amdgcn_mfma_f32_16x16x32_bf16(Bt[n][k], At[m][k], acc[ai][bj][m][n], 0, 0, 0); __builtin_amdgcn_s_setprio(0); } while (0)
#if SAFE_VM
#define PG8_WAIT_V(n) asm volatile("s_waitcnt vmcnt(0)" ::: "memory")
#else
#define PG8_WAIT_V(n) asm volatile("s_waitcnt vmcnt(" #n ")" ::: "memory")
#endif
#define PG8_WAIT_L(n) asm volatile("s_waitcnt lgkmcnt(" #n ")" ::: "memory")
#define PG8_BAR __builtin_amdgcn_s_barrier()
#define PG8_SCHED __builtin_amdgcn_sched_barrier(0)
    Unit cur, nxt; int ui = 0;
    if (!S.next(0, cur)) return;
    f32x4 acc[2][2][4][2];
#pragma unroll
    for (int a = 0; a < 2; ++a)
#pragma unroll
        for (int b = 0; b < 2; ++b)
#pragma unroll
            for (int m = 0; m < 4; ++m)
#pragma unroll
                for (int n = 0; n < 2; ++n) acc[a][b][m][n] = (f32x4){0.f, 0.f, 0.f, 0.f};
    bf16x8 At[4][2], B0[2][2], B1[2][2];
    const char* cA = (const char*)g.A + (size_t)cur.pm * tstepA + (size_t)cur.ko * 2; const char* cB = (const char*)g.Bt + (size_t)cur.pn * tstepB + (size_t)cur.ko * 2;
    PG8_STAGE(PG8_SB(0, 0), cB, voffB); PG8_STAGE(PG8_SA(0, 0), cA, voffA); PG8_STAGE(PG8_SB(0, 1), cB + hstepB, voffB); PG8_STAGE(PG8_SA(0, 1), cA + hstepA, voffA);
    if (wr == 1) PG8_BAR;
    PG8_WAIT_V(4); PG8_BAR;
    PG8_STAGE(PG8_SB(1, 0), cB + kstep, voffB); PG8_STAGE(PG8_SA(1, 0), cA + kstep, voffA); PG8_STAGE(PG8_SB(1, 1), cB + hstepB + kstep, voffB);
    PG8_WAIT_V(6); PG8_BAR;
    for (;;) {
        const bool has_next = S.next(ui + 1, nxt);
        const char* nA = has_next ? (const char*)g.A + (size_t)nxt.pm * tstepA + (size_t)nxt.ko * 2 : cA; const char* nB = has_next ? (const char*)g.Bt + (size_t)nxt.pn * tstepB + (size_t)nxt.ko * 2 : cB;
        for (int t = 0; t < nt; t += 2) {
            const bool last = (t == nt - 2);
            const char* a1 = cA + (size_t)(t + 1) * kstep;
            const char* a2 = last ? nA : cA + (size_t)(t + 2) * kstep; const char* b2 = last ? nB : cB + (size_t)(t + 2) * kstep;
            const char* a3 = a2 + kstep; const char* b3 = b2 + kstep;
            PG8_LDB(B0, 0, 0); PG8_SCHED; PG8_LDA(At, 0, 0); PG8_STAGE(PG8_SA(1, 1), a1 + hstepA, voffA);
            PG8_WAIT_L(8); PG8_BAR; PG8_WAIT_L(0); PG8_MMA(0, 0, At, B0); PG8_BAR; PG8_SCHED;
            PG8_LDB(B1, 0, 1); PG8_STAGE(PG8_SB(0, 0), b2, voffB);
            PG8_BAR; PG8_WAIT_L(0); PG8_MMA(0, 1, At, B1); PG8_BAR;
            PG8_LDA(At, 0, 1); PG8_STAGE(PG8_SA(0, 0), a2, voffA);
            PG8_BAR; PG8_WAIT_L(0); PG8_MMA(1, 0, At, B0); PG8_BAR; PG8_SCHED;
            PG8_STAGE(PG8_SB(0, 1), b2 + hstepB, voffB);
            PG8_WAIT_V(6); PG8_BAR; PG8_MMA(1, 1, At, B1); PG8_BAR;
            PG8_LDB(B0, 1, 0); PG8_SCHED; PG8_LDA(At, 1, 0); PG8_STAGE(PG8_SA(0, 1), a2 + hstepA, voffA);
            PG8_WAIT_L(8); PG8_BAR; PG8_WAIT_L(0); PG8_MMA(0, 0, At, B0); PG8_BAR; PG8_SCHED;
            PG8_LDB(B1, 1, 1); PG8_STAGE(PG8_SB(1, 0), b3, voffB);
            PG8_BAR; PG8_WAIT_L(0); PG8_MMA(0, 1, At, B1); PG8_BAR;
            PG8_LDA(At, 1, 1); PG8_STAGE(PG8_SA(1, 0), a3, voffA);
            PG8_BAR; PG8_WAIT_L(0); PG8_MMA(1, 0, At, B0); PG8_BAR; PG8_SCHED;
            PG8_STAGE(PG8_SB(1, 1), b3 + hstepB, voffB);
            PG8_WAIT_V(6); PG8_BAR; PG8_MMA(1, 1, At, B1); PG8_BAR;
        }
        { int fr_e = fr, fq_e = fq, wr_e = wr, wc_e = wc; asm volatile("" : "+v"(fr_e), "+v"(fq_e), "+s"(wr_e), "+s"(wc_e));
          E(acc, cur, wr_e, wc_e, fr_e, fq_e); }
        if (!has_next) break;
#pragma unroll
        for (int a = 0; a < 2; ++a)
#pragma unroll
            for (int b = 0; b < 2; ++b)
#pragma unroll
                for (int m = 0; m < 4; ++m)
#pragma unroll
                    for (int n = 0; n < 2; ++n) acc[a][b][m][n] = (f32x4){0.f, 0.f, 0.f, 0.f};
        cur = nxt; cA = nA; cB = nB; ++ui;
    }
    PG8_WAIT_V(0);
    if (wr == 0) PG8_BAR;
    PG8_BAR;
#undef PG8_SA
#undef PG8_SB
#undef PG8_STAGE
#undef PG8_LDA
#undef PG8_LDB
#undef PG8_MMA
#undef PG8_WAIT_V
#undef PG8_WAIT_L
#undef PG8_BAR
#undef PG8_SCHED
}

#define EPI_ARGS const f32x4 (&acc)[2][2][4][2], const Unit& u, int wr, int wc, int fr, int fq
#define FOR_AI_M _Pragma("unroll") for (int ai = 0; ai < 2; ++ai) _Pragma("unroll") for (int m = 0; m < 4; ++m) if ((__builtin_amdgcn_sched_barrier(0), true))

struct EpiZ {
    static constexpr bool PERM = true;
    bf16_t *Q, *Kb, *VT, *FA, *SA;
    __device__ __forceinline__ void operator()(EPI_ARGS) const {
        const int row0 = u.pm * BM + wr * 64 + fr, colt = wc * 32 + 8 * fq, pn = u.pn;
        if (pn == 0 || pn == 5 || pn == 6) {
            bf16_t* base = pn == 0 ? FA : VT; const int rpb = pn == 0 ? 256 : 512, coff = pn == 6 ? 256 : 0;
            FOR_AI_M { const int tok = row0 + ai * HALF + m * 16, b = tok >> 13, s = tok & 8191;
#pragma unroll
                for (int bj = 0; bj < 2; ++bj)
#pragma unroll
                    for (int n = 0; n < 2; ++n)
#pragma unroll
                        for (int j = 0; j < 4; ++j) { const int col = coff + bj * HALF + colt + 4 * n + j;
                            base[(size_t)(b * rpb + col) * 8192 + s] = f2bf(acc[ai][bj][m][n][j]); } }
        } else if (pn == 7) {
            FOR_AI_M { const int tok = row0 + ai * HALF + m * 16;
#pragma unroll
                for (int bj = 0; bj < 2; ++bj) { const int col = bj * HALF + colt, g = col >> 4, c = col & 15;
                    *(u32x4*)(SA + ((size_t)(g * 2048 + (tok >> 4)) * 512 + (tok & 15) * 16 + c)) = pack8(acc[ai][bj][m][0], acc[ai][bj][m][1]); } }
        } else {
            bf16_t* base = pn <= 2 ? Q : Kb; const int coff = ((pn - 1) & 1) * 256;
            FOR_AI_M { const int tok = row0 + ai * HALF + m * 16;
#pragma unroll
                for (int bj = 0; bj < 2; ++bj) *(u32x4*)(base + (size_t)tok * 512 + coff + bj * HALF + colt) = pack8(acc[ai][bj][m][0], acc[ai][bj][m][1]); }
        }
    }
};
struct EpiGate {
    static constexpr bool PERM = true;
    bf16_t* G;
    __device__ __forceinline__ void operator()(EPI_ARGS) const {
        const int row0 = u.pm * BM + wr * 64 + fr, colt = (u.pn & 3) * 256 + wc * 32 + 8 * fq;
        bf16_t* base = G + (size_t)(u.pn >> 2) * NTOK * 1024;
        FOR_AI_M { const int tok = row0 + ai * HALF + m * 16;
#pragma unroll
            for (int bj = 0; bj < 2; ++bj) { f32x4 a = acc[ai][bj][m][0], b = acc[ai][bj][m][1];
#pragma unroll
                for (int j = 0; j < 4; ++j) { a[j] = sigmoidf_(a[j]); b[j] = sigmoidf_(b[j]); }
                *(u32x4*)(base + (size_t)tok * 1024 + colt + bj * HALF) = pack8(a, b); } }
    }
};
struct EpiFour {
    static constexpr bool PERM = false;
    float* RF;
    __device__ __forceinline__ void operator()(EPI_ARGS) const {
        const int row0 = u.pm * BM + wr * 64 + fr, k0 = (u.pn & 15) * 256 + wc * 32 + 4 * fq; const bool cosTile = u.pn < 16;
        float* base = RF + (size_t)u.kh * 1024 * 4096;
        FOR_AI_M { const int row = row0 + ai * HALF + m * 16; const bool isP = (row & 63) <= 32;
            if (isP == cosTile) {
#pragma unroll
                for (int bj = 0; bj < 2; ++bj)
#pragma unroll
                    for (int n = 0; n < 2; ++n) *(f32x4*)(base + (size_t)row * 4096 + k0 + bj * HALF + n * 16) = acc[ai][bj][m][n]; } }
    }
};
struct EpiF32 {
    static constexpr bool PERM = false;
    float* C; int ldc;
    __device__ __forceinline__ void operator()(EPI_ARGS) const {
        const int row0 = u.pm * BM + wr * 64 + fr, col0 = wc * 32 + 4 * fq;
        FOR_AI_M { float* rowp = C + (size_t)(row0 + ai * HALF + m * 16) * ldc + col0;
#pragma unroll
            for (int bj = 0; bj < 2; ++bj)
#pragma unroll
                for (int n = 0; n < 2; ++n) *(f32x4*)(rowp + bj * HALF + n * 16) = acc[ai][bj][m][n]; }
    }
};
struct EpiSsmY {
    static constexpr bool PERM = true;
    bf16_t* YG;
    __device__ __forceinline__ void operator()(EPI_ARGS) const {
        const int row0 = u.pm * BM + wr * 64 + fr, colt = wc * 32 + 8 * fq;
        FOR_AI_M { const int row = row0 + ai * HALF + m * 16, g = row >> 11, t16 = row & 2047;
#pragma unroll
            for (int bj = 0; bj < 2; ++bj) { const int col = bj * HALF + colt, t = col >> 4, c0 = col & 15; f32x4 a = acc[ai][bj][m][0], b = acc[ai][bj][m][1];
#pragma unroll
                for (int j = 0; j < 4; ++j) { a[j] = gelu_tanh(a[j]); b[j] = gelu_tanh(b[j]); }
                *(u32x4*)(YG + (size_t)(t16 * 16 + t) * 256 + g * 16 + c0) = pack8(a, b); } }
    }
};
struct EpiGlu {
    static constexpr bool PERM = true;
    const bf16_t* YG; bf16_t* OUT;
    __device__ __forceinline__ void operator()(EPI_ARGS) const {
        const int row0 = u.pm * BM + wr * 64 + fr, colt = wc * 32 + 8 * fq;
        FOR_AI_M { const int tok = row0 + ai * HALF + m * 16;
#pragma unroll
            for (int bj = 0; bj < 2; ++bj) { const size_t o = (size_t)tok * 256 + colt + bj * HALF; const u32x4 y = *(const u32x4*)(YG + o);
                f32x4 a = acc[ai][bj][m][0], b = acc[ai][bj][m][1];
                a[0] = bflo(y.x) * sigmoidf_(a[0]); a[1] = bfhi(y.x) * sigmoidf_(a[1]); a[2] = bflo(y.y) * sigmoidf_(a[2]); a[3] = bfhi(y.y) * sigmoidf_(a[3]);
                b[0] = bflo(y.z) * sigmoidf_(b[0]); b[1] = bfhi(y.z) * sigmoidf_(b[1]); b[2] = bflo(y.w) * sigmoidf_(b[2]); b[3] = bfhi(y.w) * sigmoidf_(b[3]);
                *(u32x4*)(OUT + o) = pack8(a, b); } }
    }
};
template <bool FIRST> struct EpiMerge {
    static constexpr bool PERM = true;
    const bf16_t* G; bf16_t* MRG; float mul;
    __device__ __forceinline__ void operator()(EPI_ARGS) const {
        const int row0 = u.pm * BM + wr * 64 + fr, colt = u.pn * 256 + wc * 32 + 8 * fq;
        FOR_AI_M { const int tok = row0 + ai * HALF + m * 16;
#pragma unroll
            for (int bj = 0; bj < 2; ++bj) { const size_t o = (size_t)tok * 1024 + colt + bj * HALF; const u32x4 gq = *(const u32x4*)(G + o);
                f32x4 a = acc[ai][bj][m][0] * mul, b = acc[ai][bj][m][1] * mul;
                if (GCONST) { a = a * 0.5f; b = b * 0.5f; } else { a[0] *= bflo(gq.x); a[1] *= bfhi(gq.x); a[2] *= bflo(gq.y); a[3] *= bfhi(gq.y); b[0] *= bflo(gq.z); b[1] *= bfhi(gq.z); b[2] *= bflo(gq.w); b[3] *= bfhi(gq.w); }
                if (!FIRST) { const u32x4 o4 = *(const u32x4*)(MRG + o);
                    a[0] += bflo(o4.x); a[1] += bfhi(o4.x); a[2] += bflo(o4.y); a[3] += bfhi(o4.y); b[0] += bflo(o4.z); b[1] += bfhi(o4.z); b[2] += bflo(o4.w); b[3] += bfhi(o4.w); }
                *(u32x4*)(MRG + o) = pack8(a, b); } }
    }
};
struct EpiRes {
    static constexpr bool PERM = false;
    const float* src; float* dst;
    __device__ __forceinline__ void operator()(EPI_ARGS) const {
        const int row0 = u.pm * BM + wr * 64 + fr, col0 = u.pn * 256 + wc * 32 + 4 * fq;
        FOR_AI_M { const size_t ro = (size_t)(row0 + ai * HALF + m * 16) * 1024 + col0;
#pragma unroll
            for (int bj = 0; bj < 2; ++bj)
#pragma unroll
                for (int n = 0; n < 2; ++n) { const size_t o = ro + bj * HALF + n * 16; *(f32x4*)(dst + o) = *(const f32x4*)(src + o) + acc[ai][bj][m][n]; } }
    }
};
struct EpiUp {
    static constexpr bool PERM = true;
    bf16_t* HID;
    __device__ __forceinline__ void operator()(EPI_ARGS) const {
        const int row0 = u.pm * BM + wr * 64 + fr, colt = u.pn * 256 + wc * 32 + 8 * fq;
        FOR_AI_M { const int tok = row0 + ai * HALF + m * 16;
#pragma unroll
            for (int bj = 0; bj < 2; ++bj) { f32x4 a = acc[ai][bj][m][0], b = acc[ai][bj][m][1];
#pragma unroll
                for (int j = 0; j < 4; ++j) { const float x = fmaxf(a[j], 0.f), y = fmaxf(b[j], 0.f); a[j] = x * x; b[j] = y * y; }
                *(u32x4*)(HID + (size_t)tok * 4096 + colt + bj * HALF) = pack8(a, b); } }
    }
};

template <bool TO_BF16>
__device__ __forceinline__ void norm_row_out(const f32x4 (&v)[4], float ss, const float* gam, void* outp, int row, int lane) {
    const float rstd = rsqrtf(wave_sum(ss) * (1.0f / 1024.0f) + 1e-6f);
#pragma unroll
    for (int j = 0; j < 4; ++j) { const f32x4 gv = ((const f32x4*)gam)[lane + 64 * j]; const f32x4 y = v[j] * rstd * gv;
        if (TO_BF16) { u32x2 w; w.x = cvt_pk_bf16(y[0], y[1]); w.y = cvt_pk_bf16(y[2], y[3]); ((u32x2*)((bf16_t*)outp + (size_t)row * 1024))[lane + 64 * j] = w; }
        else ((f32x4*)((float*)outp + (size_t)row * 1024))[lane + 64 * j] = y; }
}
template <bool TO_BF16>
__device__ __forceinline__ void norm_phase(const float* x, const float* gam, void* outp, int gw, int ngw, int lane) {
    for (int row = gw; row < NTOK; row += 2 * ngw) {
        const int row2 = row + ngw; const bool has2 = row2 < NTOK;
        const f32x4* xr = (const f32x4*)(x + (size_t)row * 1024) + lane; const f32x4* xr2 = (const f32x4*)(x + (size_t)(has2 ? row2 : row) * 1024) + lane;
        f32x4 v[4], w[4]; float s = 0.f, s2 = 0.f;
#pragma unroll
        for (int j = 0; j < 4; ++j) { v[j] = xr[64 * j]; w[j] = xr2[64 * j]; }
#pragma unroll
        for (int j = 0; j < 4; ++j) { s += (v[j][0] * v[j][0] + v[j][1] * v[j][1]) + (v[j][2] * v[j][2] + v[j][3] * v[j][3]); s2 += (w[j][0] * w[j][0] + w[j][1] * w[j][1]) + (w[j][2] * w[j][2] + w[j][3] * w[j][3]); }
        norm_row_out<TO_BF16>(v, s, gam, outp, row, lane);
        if (has2) norm_row_out<TO_BF16>(w, s2, gam, outp, row2, lane);
    }
}

__device__ __forceinline__ void transpose_job(const float* W, int K, int ldw, int ncols, int c0, bf16_t* WT, int r0, float scale, LAS float* scr, int gw, int ngw, int lane) {
    const int nnb = ncols / 32, nitems = (K / 64) * nnb;
    for (int it = gw; it < nitems; it += ngw) {
        const int kb = it / nnb, nb = it % nnb, k0 = kb * 64, n0 = nb * 32;
#pragma unroll 8
        for (int i = 0; i < 32; ++i) { const int kk = 2 * i + (lane >> 5); scr[kk * 33 + (lane & 31)] = W[(size_t)(k0 + kk) * ldw + c0 + n0 + (lane & 31)]; }
        asm volatile("s_waitcnt lgkmcnt(0)" ::: "memory");
        const int c = lane & 7;
#pragma unroll
        for (int j = 0; j < 4; ++j) { const int n = (lane >> 3) + 8 * j; const LAS float* sp = scr + (8 * c) * 33 + n;
            u32x4 o; o.x = cvt_pk_bf16(sp[0] * scale, sp[33] * scale); o.y = cvt_pk_bf16(sp[66] * scale, sp[99] * scale); o.z = cvt_pk_bf16(sp[132] * scale, sp[165] * scale); o.w = cvt_pk_bf16(sp[198] * scale, sp[231] * scale);
            *(u32x4*)(WT + (size_t)(r0 + n0 + n) * K + k0 + 8 * c) = o; }
        asm volatile("s_waitcnt lgkmcnt(0)" ::: "memory");
    }
}

__device__ __forceinline__ void na_phase(const bf16_t* Q, const bf16_t* Kb, const bf16_t* VT, const LAS float* rpb, bf16_t* OUT, int gw, int ngw, int lane) {
    const int fr = lane & 15, fq = lane >> 4;
    for (int unit = gw; unit < 8192; unit += ngw) {
        const int j = unit & 3, rp = (unit >> 2) & 63, h = (unit >> 8) & 7, b = unit >> 11;
        const int r0 = rp * 2, r1 = r0 + 1;
        const int kra = min(max(r0 - 4, 0), 120), krb = min(max(r1 - 4, 0), 120), dsh = krb - kra, cs = min(max(16 * j - 8, 0), 32);
        const size_t tok0 = (size_t)b * 8192 + r0 * 64 + j * 16 + fr;
        const bf16_t* qp = Q + tok0 * 512 + h * 64 + fq * 8;
        const bf16x8 qa0 = *(const bf16x8*)qp, qa1 = *(const bf16x8*)(qp + 32), qb0 = *(const bf16x8*)(qp + 64 * 512), qb1 = *(const bf16x8*)(qp + 64 * 512 + 32);
        f32x4 sa[9][2], sb[9][2];
#pragma unroll
        for (int ub = 0; ub < 3; ++ub) {
            bf16x8 kf[3][2][2];
#pragma unroll
            for (int uu = 0; uu < 3; ++uu) { const int krow = min(kra + ub * 3 + uu, 127);
#pragma unroll
                for (int t = 0; t < 2; ++t) { const int kc = cs + (fr >> 2) * 8 + t * 4 + (fr & 3);
                    const bf16_t* kp = Kb + ((size_t)b * 8192 + krow * 64 + kc) * 512 + h * 64 + fq * 8; kf[uu][t][0] = *(const bf16x8*)kp; kf[uu][t][1] = *(const bf16x8*)(kp + 32); } }
            asm volatile("" ::: "memory");
#pragma unroll
            for (int uu = 0; uu < 3; ++uu)
#pragma unroll
                for (int t = 0; t < 2; ++t) { f32x4 a = (f32x4){0.f, 0.f, 0.f, 0.f}, c = (f32x4){0.f, 0.f, 0.f, 0.f};
                    a = __builtin_amdgcn_mfma_f32_16x16x32_bf16(kf[uu][t][0], qa0, a, 0, 0, 0); c = __builtin_amdgcn_mfma_f32_16x16x32_bf16(kf[uu][t][0], qb0, c, 0, 0, 0);
                    a = __builtin_amdgcn_mfma_f32_16x16x32_bf16(kf[uu][t][1], qa1, a, 0, 0, 0); c = __builtin_amdgcn_mfma_f32_16x16x32_bf16(kf[uu][t][1], qb1, c, 0, 0, 0);
                    sa[ub * 3 + uu][t] = a; sb[ub * 3 + uu][t] = c; }
        }
        const int qcol = 16 * j + fr, wsq = min(max(qcol - 8, 0), 48);
        const LAS float* bias_h = rpb + h * 15 * 31;
        float mxa = -1e30f, mxb = -1e30f;
#pragma unroll
        for (int u = 0; u < 9; ++u) { const int krow = kra + u; const bool va = u <= 7, vb = (u >= dsh) && (u <= 7 + dsh);
            const int dra = min(max(krow - r0 + 7, 0), 14), drb = min(max(krow - r1 + 7, 0), 14);
#pragma unroll
            for (int t = 0; t < 2; ++t)
#pragma unroll
                for (int jj = 0; jj < 4; ++jj) { const int kc = cs + fq * 8 + t * 4 + jj; const bool inw = (kc >= wsq) && (kc < wsq + 16); const int dc = min(max(kc - qcol, -15), 15) + 15;
                    const float xa = (va && inw) ? sa[u][t][jj] + bias_h[dra * 31 + dc] : -1e30f; const float xb = (vb && inw) ? sb[u][t][jj] + bias_h[drb * 31 + dc] : -1e30f;
                    sa[u][t][jj] = xa; sb[u][t][jj] = xb; mxa = fmaxf(mxa, xa); mxb = fmaxf(mxb, xb); } }
        mxa = fmaxf(mxa, __shfl_xor(mxa, 16)); mxa = fmaxf(mxa, __shfl_xor(mxa, 32)); mxb = fmaxf(mxb, __shfl_xor(mxb, 16)); mxb = fmaxf(mxb, __shfl_xor(mxb, 32));
        float suma = 0.f, sumb = 0.f;
#pragma unroll
        for (int u = 0; u < 9; ++u)
#pragma unroll
            for (int t = 0; t < 2; ++t)
#pragma unroll
                for (int jj = 0; jj < 4; ++jj) { const float xa = sa[u][t][jj], xb = sb[u][t][jj]; const float pa = xa > -1e29f ? __expf(xa - mxa) : 0.f, pb = xb > -1e29f ? __expf(xb - mxb) : 0.f;
                    sa[u][t][jj] = pa; sb[u][t][jj] = pb; suma += pa; sumb += pb; }
        suma += __shfl_xor(suma, 16); suma += __shfl_xor(suma, 32); sumb += __shfl_xor(sumb, 16); sumb += __shfl_xor(sumb, 32);
        f32x4 oa[4], ob[4];
#pragma unroll
        for (int dt = 0; dt < 4; ++dt) { oa[dt] = (f32x4){0.f, 0.f, 0.f, 0.f}; ob[dt] = (f32x4){0.f, 0.f, 0.f, 0.f}; }
#pragma unroll
        for (int ub = 0; ub < 3; ++ub) {
            bf16x8 vf[3][4];
#pragma unroll
            for (int uu = 0; uu < 3; ++uu) { const int krow = min(kra + ub * 3 + uu, 127);
#pragma unroll
                for (int dt = 0; dt < 4; ++dt) vf[uu][dt] = *(const bf16x8*)(VT + ((size_t)b * 512 + h * 64 + dt * 16 + fr) * 8192 + krow * 64 + cs + fq * 8); }
            asm volatile("" ::: "memory");
#pragma unroll
            for (int uu = 0; uu < 3; ++uu) { const int u = ub * 3 + uu;
                const bf16x8 pfa = __builtin_bit_cast(bf16x8, pack8(sa[u][0], sa[u][1])), pfb = __builtin_bit_cast(bf16x8, pack8(sb[u][0], sb[u][1]));
#pragma unroll
                for (int dt = 0; dt < 4; ++dt) { oa[dt] = __builtin_amdgcn_mfma_f32_16x16x32_bf16(vf[uu][dt], pfa, oa[dt], 0, 0, 0); ob[dt] = __builtin_amdgcn_mfma_f32_16x16x32_bf16(vf[uu][dt], pfb, ob[dt], 0, 0, 0); } }
        }
        const float inva = 1.0f / suma, invb = 1.0f / sumb;
#pragma unroll
        for (int dt = 0; dt < 4; ++dt) { u32x2 w; w.x = cvt_pk_bf16(oa[dt][0] * inva, oa[dt][1] * inva); w.y = cvt_pk_bf16(oa[dt][2] * inva, oa[dt][3] * inva);
            *(u32x2*)(OUT + tok0 * 512 + h * 64 + dt * 16 + 4 * fq) = w;
            u32x2 x; x.x = cvt_pk_bf16(ob[dt][0] * invb, ob[dt][1] * invb); x.y = cvt_pk_bf16(ob[dt][2] * invb, ob[dt][3] * invb);
            *(u32x2*)(OUT + (tok0 + 64) * 512 + h * 64 + dt * 16 + 4 * fq) = x; }
    }
}

__device__ __forceinline__ void fold_phase(const bf16_t* FA, bf16_t* FAF, float* EXTRA, int gw, int ngw, int lane) {
    const int hw = ngw >> 1;
    for (int row = gw - hw; row >= 0 && row < 1024; row += hw) {
        const bf16_t* src = FA + (size_t)row * 8192; bf16_t* dst = FAF + (size_t)row * 4096;
        const float sgn = ((row & 63) <= 32) ? 1.0f : -1.0f; float dot = 0.f;
        for (int it0 = 0; it0 < 64; it0 += 16) {
            bf16_t ra[16], rb[16];
#pragma unroll
            for (int e = 0; e < 16; ++e) { const int s = (it0 + e) * 64 + lane; ra[e] = src[s]; rb[e] = src[s ? 8192 - s : 0]; }
            asm volatile("" ::: "memory");
#pragma unroll
            for (int e = 0; e < 16; ++e) { const int s = (it0 + e) * 64 + lane; const float a = bf2f(ra[e]); const float bb = s ? bf2f(rb[e]) : 0.f;
                const float v = a + sgn * bb; dst[s] = f2bf(v); dot += (s & 1) ? -v : v; }
        }
        dot = wave_sum(dot); const float mid = bf2f(src[4096]);
        if (lane == 0) { EXTRA[32 * row] = mid; EXTRA[32 * row + 1] = dot + mid; }
    }
}
__device__ __forceinline__ void tgen_phase(bf16_t* T, int gt, int ngt) {
    for (int v = gt; v < 8192 * 512; v += ngt) { const int n = v >> 9, s0 = (v & 511) * 8, k = n & 4095; const bool isSin = n >= 4096; float e[8];
#pragma unroll
        for (int i = 0; i < 8; ++i) { const float f = (float)((k * (s0 + i)) & 8191) * (1.0f / 8192.0f); e[i] = isSin ? __builtin_amdgcn_sinf(f) : __builtin_amdgcn_cosf(f); }
        u32x4 w; w.x = cvt_pk_bf16(e[0], e[1]); w.y = cvt_pk_bf16(e[2], e[3]); w.z = cvt_pk_bf16(e[4], e[5]); w.w = cvt_pk_bf16(e[6], e[7]);
        *(u32x4*)(T + (size_t)v * 8) = w; }
}
__device__ __forceinline__ void fcombine_phase(const float* RF, const float* EXTRA, bf16_t* OUTFN, LAS float* tile, int blk, int nblk, int tid) {
    const float scale = 0.001381067932f;
    const bool deal = (nblk == 256); const int nmine = deal ? (blk < 128 ? 3 : 5) : (1024 - blk + nblk - 1) / nblk, tbase = deal ? (blk < 128 ? blk * 3 : 384 + (blk - 128) * 5) : blk;
    for (int q_ = 0; q_ < nmine; ++q_) { const int ti = deal ? tbase + q_ : tbase + q_ * nblk;
        const int kt = ti & 63, g = (ti >> 6) & 3, b = ti >> 8, rowb = b * 256 + g * 64;
#pragma unroll
        for (int i = 0; i < 8; ++i) { const int idx = tid + 512 * i, kk = idx & 63, jr = idx >> 6, row = rowb + jr; const size_t o = (size_t)row * 4096 + kt * 64 + kk;
            float v = RF[o] + RF[o + (size_t)1024 * 4096];
            if (jr <= 32) { const float e = EXTRA[32 * row]; v += (kk & 1) ? -e : e; }
            tile[jr * 65 + kk] = v; }
        __syncthreads();
#pragma unroll
        for (int i = 0; i < 16; ++i) { const int o = tid + 512 * i, m = o & 63, kk = (o >> 6) & 63, side = o >> 12, kp = kt * 64 + kk;
            const int mp = m <= 32 ? m : 64 - m; float sg = m <= 32 ? -1.f : 1.f; if (side) sg = -sg;
            float A = tile[mp * 65 + kk]; float B = (mp == 0 || mp == 32) ? 0.f : tile[(32 + mp) * 65 + kk];
            int k;
            if (side == 0) k = kp; else if (kp != 0) k = 8192 - kp; else { k = 4096; A = EXTRA[32 * (rowb + mp) + 1]; B = 0.f; }
            if (!FC_NOSTORE || A == 123456.789f) OUTFN[((size_t)b * 8192 + k) * 256 + g * 64 + m] = f2bf((A + sg * B) * scale); }
        __syncthreads();
    }
}

__device__ __forceinline__ void scan_phase(const float* XLOC, bf16_t* SA, const f32x2* LPl, LAS float* sh, int blk, int tid) {
    if (blk >= 128) return;
    const int d = blk & 1, g = (blk >> 1) & 15, b = blk >> 5, p = tid & 63, seg = tid >> 6;
    const f32x2 lt = LPl[(((size_t)d * 16 + g) * 64 + p) * 17 + 16];
    const size_t rowbase = (size_t)g * 2048 + b * 512;
    const float lr = lt[0], li = lt[1];
    float ar = 0.f, ai = 0.f;
    for (int i0 = 0; i0 < 64; i0 += 16) { float xr[16], xi[16];
#pragma unroll
        for (int e = 0; e < 16; ++e) { const int i = seg * 64 + i0 + e, ch = d ? 511 - i : i; const float* px = XLOC + (rowbase + ch) * 256 + d * 128 + p; xr[e] = px[0]; xi[e] = px[64]; }
#pragma unroll
        for (int e = 0; e < 16; ++e) { const float nr = lr * ar - li * ai + xr[e], ni = lr * ai + li * ar + xi[e]; ar = nr; ai = ni; } }
    sh[(seg * 64 + p) * 2] = ar; sh[(seg * 64 + p) * 2 + 1] = ai;
    __syncthreads();
    float l64r = lr, l64i = li;
#pragma unroll
    for (int q = 0; q < 6; ++q) { const float nr = l64r * l64r - l64i * l64i, ni = 2.f * l64r * l64i; l64r = nr; l64i = ni; }
    float Xr = 0.f, Xi = 0.f;
    for (int k = 0; k < seg; ++k) { const float sr = sh[(k * 64 + p) * 2], si = sh[(k * 64 + p) * 2 + 1]; const float nr = l64r * Xr - l64i * Xi + sr, ni = l64r * Xi + l64i * Xr + si; Xr = nr; Xi = ni; }
    for (int i0 = 0; i0 < 64; i0 += 16) { float xr[16], xi[16];
#pragma unroll
        for (int e = 0; e < 16; ++e) { const int i = seg * 64 + i0 + e, ch = d ? 511 - i : i; const float* px = XLOC + (rowbase + ch) * 256 + d * 128 + p; xr[e] = px[0]; xi[e] = px[64]; }
#pragma unroll
        for (int e = 0; e < 16; ++e) { const int i = seg * 64 + i0 + e, ch = d ? 511 - i : i; bf16_t* ps = SA + (rowbase + ch) * 512 + 256 + d * 128 + p;
            ps[0] = f2bf(Xr); ps[64] = f2bf(Xi);
            const float nr = lr * Xr - li * Xi + xr[e], ni = lr * Xi + li * Xr + xi[e]; Xr = nr; Xi = ni; } }
    __syncthreads();
}

__device__ __forceinline__ void ssm_prep_a(const float* log_dt, const float* a_re, const float* a_im, const float* b_re, const float* b_im, f32x2* LP, f32x2* BB, int gt, int ngt) {
    for (int i = gt; i < NLAYER * 2 * 16 * 64; i += ngt) {
        const int ldg = i >> 6;
        const double dt = (double)__expf(log_dt[ldg]);
        const double are = (double)a_re[i], aim = (double)a_im[i];
        const float mag = __expf((float)(are * dt));
        const double ang = aim * dt; const double rr = ang - 6.283185307179586 * rint(ang * 0.15915494309189535);
        const double q = rr * 0.125, q2 = q * q;
        double s = q * (1.0 - q2 / 6.0 * (1.0 - q2 / 20.0 * (1.0 - q2 / 42.0 * (1.0 - q2 / 72.0 * (1.0 - q2 / 110.0 * (1.0 - q2 / 156.0))))));
        double c = 1.0 - q2 / 2.0 * (1.0 - q2 / 12.0 * (1.0 - q2 / 30.0 * (1.0 - q2 / 56.0 * (1.0 - q2 / 90.0 * (1.0 - q2 / 132.0)))));
#pragma unroll
        for (int k = 0; k < 3; ++k) { const double s2 = 2.0 * s * c, c2 = 1.0 - 2.0 * s * s; s = s2; c = c2; }
        const double lbr = (double)mag * c, lbi = (double)mag * s;
        double pr = 1.0, pi = 0.0;
        for (int tau = 0; tau <= 16; ++tau) { LP[(size_t)i * 17 + tau] = (f32x2){(float)pr, (float)pi}; const double nr = pr * lbr - pi * lbi, ni = pr * lbi + pi * lbr; pr = nr; pi = ni; }
        const double nr_ = lbr - 1.0, ni_ = lbi, den = are * are + aim * aim; const double fr_ = (nr_ * are + ni_ * aim) / den, fi_ = (ni_ * are - nr_ * aim) / den;
        for (int c_ = 0; c_ < 16; ++c_) { const double br = (double)b_re[(size_t)i * 16 + c_], bi = (double)b_im[(size_t)i * 16 + c_];
            BB[(size_t)i * 16 + c_] = (f32x2){(float)(fr_ * br - fi_ * bi), (float)(fr_ * bi + fi_ * br)}; }
    }
}
__device__ __forceinline__ void ssm_prep_b(const float* c_re, const float* c_im, const f32x2* LP, const f32x2* BB, float* KT, int gt, int ngt) {
    for (int i = gt; i < NLAYER * 2 * 16 * 16 * 256; i += ngt) {
        const int cp = i & 15, c = (i >> 4) & 15, tau = (i >> 8) & 15, ldg = i >> 12;
        const float* cre = c_re + ((size_t)ldg * 16 + c) * 64; const float* cim = c_im + ((size_t)ldg * 16 + c) * 64;
        float accv = 0.f;
        for (int p = 0; p < 64; ++p) { const f32x2 l = LP[((size_t)ldg * 64 + p) * 17 + tau], bb = BB[((size_t)ldg * 64 + p) * 16 + cp];
            const float tr = l[0] * bb[0] - l[1] * bb[1], ti = l[0] * bb[1] + l[1] * bb[0]; accv += cre[p] * tr - cim[p] * ti; }
        KT[i] = accv;
    }
}
__device__ __forceinline__ void ssm_fill(const float* c_re, const float* c_im, const float* d_skip, int l, const f32x2* LP, const f32x2* BB, const float* KT, bf16_t* BT1, bf16_t* BT2, int gt, int ngt) {
    const f32x2* LPl = LP + (size_t)l * 2 * 16 * 64 * 17; const f32x2* BBl = BB + (size_t)l * 2 * 16 * 64 * 16; const float* KTl = KT + (size_t)l * 2 * 16 * 16 * 256;
    for (int i = gt; i < 16 * 256 * 256; i += ngt) {
        const int col = i & 255, jrow = (i >> 8) & 255, g = i >> 16, tp = col >> 4, cp = col & 15, d = jrow >> 7, p = jrow & 63; const bool im = (jrow & 64) != 0;
        const f32x2 lam = LPl[(((size_t)d * 16 + g) * 64 + p) * 17 + (d ? tp : 15 - tp)], bb = BBl[(((size_t)d * 16 + g) * 64 + p) * 16 + cp];
        BT1[i] = f2bf(im ? lam[0] * bb[1] + lam[1] * bb[0] : lam[0] * bb[0] - lam[1] * bb[1]);
    }
    const float* Dl = d_skip + (size_t)l * 256; const float* Cre = c_re + (size_t)l * 2 * 16 * 16 * 64; const float* Cim = c_im + (size_t)l * 2 * 16 * 16 * 64;
    for (int i = gt; i < 16 * 256 * 512; i += ngt) {
        const int col = i & 511, row = (i >> 9) & 255, g = i >> 17, t = row >> 4, c = row & 15; float v;
        if (col < 256) { const int tp = col >> 4, cp = col & 15, tau = t - tp;
            if (tau > 0) v = KTl[(((size_t)0 * 16 + g) * 16 + tau) * 256 + c * 16 + cp];
            else if (tau < 0) v = KTl[(((size_t)1 * 16 + g) * 16 - tau) * 256 + c * 16 + cp];
            else v = KTl[(((size_t)0 * 16 + g) * 16) * 256 + c * 16 + cp] + KTl[(((size_t)1 * 16 + g) * 16) * 256 + c * 16 + cp] + (c == cp ? Dl[g * 16 + c] : 0.f);
        } else { const int jc = col - 256, d = jc >> 7, p = jc & 63; const bool im = (jc & 64) != 0;
            const f32x2 lam = LPl[(((size_t)d * 16 + g) * 64 + p) * 17 + (d ? 16 - t : t + 1)];
            const float cr = Cre[(((size_t)d * 16 + g) * 16 + c) * 64 + p], ci = Cim[(((size_t)d * 16 + g) * 16 + c) * 64 + p];
            v = im ? -(cr * lam[1] + ci * lam[0]) : (cr * lam[0] - ci * lam[1]); }
        BT2[i] = f2bf(v);
    }
}
__device__ __forceinline__ void wfold_job(const float* Win, bf16_t* WT, int gt, int ngt) {
    for (int i = gt; i < 256 * 1024; i += ngt) { const int k = i & 1023, n = i >> 10, g = n >> 6, j = n & 63; const int mm = j <= 32 ? j : j - 32; const bool isSin = j > 32;
        const float* w = Win + (size_t)k * 5120 + g * 64; float a = 0.f;
        for (int c = 0; c < 64; ++c) { const float f = (float)((mm * c) & 63) * (1.0f / 64.0f); a += w[c] * (isSin ? __builtin_amdgcn_sinf(f) : __builtin_amdgcn_cosf(f)); }
        WT[(size_t)n * 1024 + k] = f2bf(a); }
}

#ifndef SUB3
#define SUB3 3
#endif
#ifndef SUB4
#define SUB4 3
#endif
#ifndef SUB6
#define SUB6 7
#endif
#ifndef FFN_ONLY
#define FFN_ONLY 0
#endif
#ifndef ZBR
#define ZBR 0
#endif
#ifndef SUBMASK
#define SUBMASK 0xff
#endif
#ifndef PHMASK
#define PHMASK 0xffff
#endif
constexpr int LDS_BYTES = STAGE_BYTES + 20480;
constexpr int PH_PER_LAYER = 11, PH_INIT = 2, PH_TOTAL = PH_INIT + NLAYER * PH_PER_LAYER + 1;

__global__ void __launch_bounds__(512, 2) fwd_megakernel(Params P) {
    extern __shared__ __attribute__((aligned(16))) unsigned char shm[];
    LAS unsigned char* lds = (LAS unsigned char*)shm;
    LAS float* ldsf = (LAS float*)(shm + STAGE_BYTES);
    cg::grid_group grid = cg::this_grid();
    const int blk = blockIdx.x, nblk = gridDim.x;
    const int ph_lo = P.ph_lo, ph_hi = P.ph_hi;
    grid.sync();
#define KA __attribute__((address_space(4)))
#define FRESH_IDS int tid = threadIdx.x; asm volatile("" : "+v"(tid)); const int lane = tid & 63, wave = tid >> 6, gw = blk * 8 + wave, ngw = nblk * 8, gt = blk * 512 + tid, ngt = nblk * 512; (void)lane; (void)gw; (void)ngw; (void)gt; (void)ngt;
#define WSP(T, off) ((T*)(ws + (off)))
    for (int ph = ph_lo; ph < ph_hi; ++ph) {
        const KA Params* kp = (const KA Params*)__builtin_amdgcn_kernarg_segment_ptr();
        asm volatile("" : "+s"(kp));
        unsigned char* ws = kp->ws;
        if (LDS_CLEAR) { int t_ = threadIdx.x; asm volatile("" : "+v"(t_)); for (int z = t_; z < STAGE_BYTES / 16; z += 512) ((LAS u32x4*)lds)[z] = (u32x4){0u, 0u, 0u, 0u}; __syncthreads(); }
        if (ph == 0) { if constexpr ((PHMASK >> 11) & 1) { FRESH_IDS; ssm_prep_a(kp->in[6], kp->in[4], kp->in[5], kp->in[7], kp->in[8], WSP(f32x2, WS_LP), WSP(f32x2, WS_BB), gt, ngt); } }
        else if (ph == 1) { if constexpr ((PHMASK >> 11) & 1) { FRESH_IDS; ssm_prep_b(kp->in[9], kp->in[10], WSP(f32x2, WS_LP), WSP(f32x2, WS_BB), WSP(float, WS_KT), gt, ngt); } }
        else if (ph == PH_TOTAL - 1) { FRESH_IDS; norm_phase<false>(kp->out, kp->in[20], kp->out, gw, ngw, lane); }
        else {
            const int l = (ph - PH_INIT) / PH_PER_LAYER, lp = (ph - PH_INIT) % PH_PER_LAYER;
            switch (lp) {
            case 0: if constexpr ((PHMASK >> 0) & 1) {
                const float* Win = kp->in[2] + (size_t)l * 1024 * 5120;
                { FRESH_IDS; LAS float* wscr = (LAS float*)(lds + wave * 16384);
                transpose_job(Win, 1024, 5120, 512, 256, WSP(bf16_t, W_IN), 256, 0.125f, wscr, gw, ngw, lane);
                transpose_job(Win, 1024, 5120, 4352, 768, WSP(bf16_t, W_IN), 768, 1.0f, wscr, gw, ngw, lane);
                transpose_job(kp->in[13] + (size_t)l * 256 * 1024, 256, 1024, 1024, 0, WSP(bf16_t, W_BRFN), 0, 1.0f, wscr, gw, ngw, lane);
                transpose_job(kp->in[14] + (size_t)l * 512 * 1024, 512, 1024, 1024, 0, WSP(bf16_t, W_BRNA), 0, 1.0f, wscr, gw, ngw, lane);
                transpose_job(kp->in[15] + (size_t)l * 256 * 1024, 256, 1024, 1024, 0, WSP(bf16_t, W_BRSSM), 0, 1.0f, wscr, gw, ngw, lane);
                transpose_job(kp->in[16] + (size_t)l * 1024 * 1024, 1024, 1024, 1024, 0, WSP(bf16_t, W_OUT), 0, 1.0f, wscr, gw, ngw, lane);
                transpose_job(kp->in[18] + (size_t)l * 1024 * 4096, 1024, 4096, 4096, 0, WSP(bf16_t, W_UP), 0, 1.0f, wscr, gw, ngw, lane);
                transpose_job(kp->in[19] + (size_t)l * 4096 * 1024, 4096, 1024, 1024, 0, WSP(bf16_t, W_DOWN), 0, 1.0f, wscr, gw, ngw, lane);
                transpose_job(kp->in[12] + (size_t)l * 256 * 256, 256, 256, 256, 0, WSP(bf16_t, W_GLU), 0, 1.0f, wscr, gw, ngw, lane);
                wfold_job(Win, WSP(bf16_t, W_IN), gt, ngt);
                ssm_fill(kp->in[9], kp->in[10], kp->in[11], l, WSP(f32x2, WS_LP), WSP(f32x2, WS_BB), WSP(float, WS_KT), WSP(bf16_t, W_BT1), WSP(bf16_t, W_BT2), gt, ngt);
                norm_phase<true>(l == 0 ? kp->in[0] : kp->out, kp->in[1] + (size_t)l * 1024, WSP(bf16_t, WS_H), gw, ngw, lane); }
            } break;
            case 1: if constexpr ((PHMASK >> 1) & 1) {
                StaticOrder S; S.init(NTOK, 2048, nblk, blk); EpiZ E{WSP(bf16_t, R1_Q), WSP(bf16_t, R1_K), WSP(bf16_t, R1_VT), WSP(bf16_t, R1_FA), WSP(bf16_t, R1_SA)};
                gemm_phase(lds, Gemm{WSP(bf16_t, WS_H), WSP(bf16_t, W_IN), 1024, 1024, 1024}, S, E);
            } break;
            case 2: if constexpr ((PHMASK >> 2) & 1) {
                if constexpr (SUBMASK & 1) { DiagOrder S{nblk, blk}; EpiF32 E{WSP(float, R1_XLOC), 256}; gemm_phase(lds, Gemm{WSP(bf16_t, R1_SA), WSP(bf16_t, W_BT1), 256, 512, 256}, S, E); }
                if constexpr (SUBMASK & 2) { FRESH_IDS; const float* rpbl = kp->in[3] + (size_t)l * 8 * 15 * 31;
                    for (int z = tid; z < 8 * 15 * 31; z += 512) ldsf[z] = rpbl[z];
                    __syncthreads();
                    na_phase(WSP(bf16_t, R1_Q), WSP(bf16_t, R1_K), WSP(bf16_t, R1_VT), ldsf, WSP(bf16_t, WS_OUTNA), gw, ngw, lane);
                    __syncthreads(); }
                if constexpr (SUBMASK & 4) { FRESH_IDS; fold_phase(WSP(bf16_t, R1_FA), WSP(bf16_t, R1_FAF), WSP(float, R1_EXTRA), gw, ngw, lane); }
                if constexpr (SUBMASK & 8) if (l == 0) { FRESH_IDS; tgen_phase(WSP(bf16_t, WS_T), gt, ngt); }
            } break;
            case 3: if constexpr ((PHMASK >> 3) & 1) {
                if constexpr (SUB3 & 1) { FourierOrder S{nblk, blk}; EpiFour E{WSP(float, R1_RF)}; gemm_phase(lds, Gemm{WSP(bf16_t, R1_FAF), WSP(bf16_t, WS_T), 2048, 4096, 4096}, S, E); }
                if constexpr (SUB3 & 2) { FRESH_IDS; scan_phase(WSP(float, R1_XLOC), WSP(bf16_t, R1_SA), WSP(f32x2, WS_LP) + (size_t)l * 2 * 16 * 64 * 17, ldsf, blk, tid); }
            } break;
            case 4: if constexpr ((PHMASK >> 4) & 1) {
                if constexpr (SUB4 & 1) { DiagOrder S{nblk, blk}; EpiSsmY E{WSP(bf16_t, R1_YG)}; gemm_phase(lds, Gemm{WSP(bf16_t, R1_SA), WSP(bf16_t, W_BT2), 512, 512, 512}, S, E); }
                if constexpr (SUB4 & 2) { FRESH_IDS; fcombine_phase(WSP(float, R1_RF), WSP(float, R1_EXTRA), WSP(bf16_t, WS_OUTFN), ldsf, blk, nblk, tid);
                    for (int z = tid; z < 64 * 65; z += 512) ldsf[z] = 0.f; __syncthreads(); }
            } break;
            case 5: if constexpr ((PHMASK >> 5) & 1) {
                if constexpr (SUBMASK & 1) { StaticOrder S; S.init(NTOK, 256, nblk, blk); EpiGlu E{WSP(bf16_t, R1_YG), WSP(bf16_t, WS_OUTSSM)}; gemm_phase(lds, Gemm{WSP(bf16_t, R1_YG), WSP(bf16_t, W_GLU), 256, 256, 256}, S, E); }
                if constexpr (SUBMASK & 2) { StaticOrder S; S.init(NTOK, 3072, nblk, blk); EpiGate E{WSP(bf16_t, R1_G)}; gemm_phase(lds, Gemm{WSP(bf16_t, WS_H), WSP(bf16_t, W_IN) + (size_t)2048 * 1024, 1024, 1024, 1024}, S, E); }
            } break;
            case 6: if constexpr ((PHMASK >> 6) & 1) {
                StaticOrder S; S.init(NTOK, 1024, nblk, blk);
                if constexpr (SUB6 & 1) { EpiMerge<true> E{WSP(bf16_t, R1_G), WSP(bf16_t, WS_H), (ZBR & 1) ? 0.f : 1.f}; gemm_phase(lds, Gemm{WSP(bf16_t, WS_OUTFN), WSP(bf16_t, W_BRFN), 256, 256, 256}, S, E); }
                if constexpr (SUB6 & 2) { EpiMerge<false> E{WSP(bf16_t, R1_G) + (size_t)NTOK * 1024, WSP(bf16_t, WS_H), (ZBR & 2) ? 0.f : 1.f}; gemm_phase(lds, Gemm{WSP(bf16_t, WS_OUTNA), WSP(bf16_t, W_BRNA), 512, 512, 512}, S, E); }
                if constexpr (SUB6 & 4) { EpiMerge<false> E{WSP(bf16_t, R1_G) + (size_t)2 * NTOK * 1024, WSP(bf16_t, WS_H), (ZBR & 4) ? 0.f : 1.f}; gemm_phase(lds, Gemm{WSP(bf16_t, WS_OUTSSM), WSP(bf16_t, W_BRSSM), 256, 256, 256}, S, E); }
            } break;
            case 7: if constexpr ((PHMASK >> 7) & 1) {
                StaticOrder S; S.init(NTOK, 1024, nblk, blk); EpiRes E{l == 0 ? kp->in[0] : kp->out, kp->out};
                gemm_phase(lds, Gemm{WSP(bf16_t, WS_H), WSP(bf16_t, W_OUT), 1024, 1024, 1024}, S, E);
            } break;
            case 8: if constexpr ((PHMASK >> 8) & 1) { FRESH_IDS; norm_phase<true>((FFN_ONLY && l == 0) ? kp->in[0] : kp->out, kp->in[17] + (size_t)l * 1024, WSP(bf16_t, WS_H), gw, ngw, lane); } break;
            case 9: if constexpr ((PHMASK >> 9) & 1) {
                StaticOrder S; S.init(NTOK, 4096, nblk, blk); EpiUp E{WSP(bf16_t, R1_HID)};
                gemm_phase(lds, Gemm{WSP(bf16_t, WS_H), WSP(bf16_t, W_UP), 1024, 1024, 1024}, S, E);
            } break;
            case 10: if constexpr ((PHMASK >> 10) & 1) {
                StaticOrder S; S.init(NTOK, 1024, nblk, blk); EpiRes E{(FFN_ONLY && l == 0) ? kp->in[0] : kp->out, kp->out};
                gemm_phase(lds, Gemm{WSP(bf16_t, R1_HID), WSP(bf16_t, W_DOWN), 4096, 4096, 4096}, S, E);
            } break;
            }
        }
        if (ph + 1 < ph_hi) {
            asm volatile("s_waitcnt vmcnt(0) lgkmcnt(0)" ::: "memory");
            __syncthreads();
            if (threadIdx.x == 0) {
                unsigned* bar = (unsigned*)(ws + WS_BAR);
                __builtin_amdgcn_fence(__ATOMIC_RELEASE, "agent"); asm volatile("s_waitcnt vmcnt(0)" ::: "memory");
                const unsigned k = (unsigned)(ph - ph_lo + 1), gsz = (unsigned)nblk >> 4;
                const unsigned old = __hip_atomic_fetch_add(bar + 16 * (1 + (blk & 15)), 1u, __ATOMIC_RELAXED, __HIP_MEMORY_SCOPE_AGENT);
                if (old + 1u == k * gsz) __hip_atomic_fetch_add(bar, 1u, __ATOMIC_RELAXED, __HIP_MEMORY_SCOPE_AGENT);
                while (__hip_atomic_load(bar, __ATOMIC_RELAXED, __HIP_MEMORY_SCOPE_AGENT) < k * 16u) __builtin_amdgcn_s_sleep(1);
                __builtin_amdgcn_fence(__ATOMIC_ACQUIRE, "agent");
                asm volatile("s_waitcnt vmcnt(0)" ::: "memory");
            }
            __syncthreads();
        }
    }
}

extern "C" void kernel_launch(void* const* d_in, const int* in_sizes, int n_in, void* d_out, int out_size, void* d_ws, size_t ws_size, hipStream_t stream) {
    static int grid_blocks = 0;
    if (!grid_blocks) {
        if (n_in != 21 || out_size != NTOK * DM || ws_size < WS_END) { fprintf(stderr, "kernel_launch: unexpected problem (n_in %d out %d ws %zu need %zu)\n", n_in, out_size, ws_size, (size_t)WS_END); grid_blocks = -1; return; }
        int dev = 0, cus = 0, per_cu = 0;
        hipGetDevice(&dev);
        hipDeviceGetAttribute(&cus, hipDeviceAttributeMultiprocessorCount, dev);
        if (hipFuncSetAttribute((const void*)fwd_megakernel, hipFuncAttributeMaxDynamicSharedMemorySize, LDS_BYTES) != hipSuccess) { fprintf(stderr, "kernel_launch: hipFuncSetAttribute failed\n"); grid_blocks = -1; return; }
        if (hipOccupancyMaxActiveBlocksPerMultiprocessor(&per_cu, (const void*)fwd_megakernel, 512, LDS_BYTES) != hipSuccess || per_cu < 1) { fprintf(stderr, "kernel_launch: occupancy query says %d\n", per_cu); per_cu = 1; }
        (void)hipGetLastError();
        grid_blocks = cus - (cus % 16);
    }
    if (grid_blocks < 0) return;
    Params p{};
    for (int i = 0; i < 21; ++i) p.in[i] = (const float*)d_in[i];
    p.out = (float*)d_out; p.ws = (unsigned char*)d_ws;
    if (hipMemsetAsync((unsigned char*)d_ws + WS_BAR, 0, 2048, stream) != hipSuccess) { fprintf(stderr, "kernel_launch: memset failed\n"); return; }
#if PER_PHASE_LAUNCH
    for (int ph = 0; ph < PH_TOTAL; ++ph) { p.ph_lo = ph; p.ph_hi = ph + 1; void* args[] = {&p};
        hipError_t e = hipLaunchCooperativeKernel((const void*)fwd_megakernel, dim3(grid_blocks), dim3(512), args, LDS_BYTES, stream);
        if (e != hipSuccess) { fprintf(stderr, "cooperative launch failed: %s (phase %d)\n", hipGetErrorString(e), ph); return; } }
#else
    p.ph_lo = 0; p.ph_hi = PH_TOTAL; void* args[] = {&p};
    hipError_t e = hipLaunchCooperativeKernel((const void*)fwd_megakernel, dim3(grid_blocks), dim3(512), args, LDS_BYTES, stream);
    if (e != hipSuccess) fprintf(stderr, "cooperative launch failed: %s (grid %d)\n", hipGetErrorString(e), grid_blocks);
#endif
}
```
